# Optimizing an MI355X kernel written in HIP

```python
import jax, jax.numpy as jnp
from jax import lax
import numpy as np

D_MODEL = 1024
BATCH = 8
SEQ = 2048
DEPTH = 2
DEC_BATCH = 2
DEC_SEQ = 16384
PAST_LEN = 128

N_MIXERS = 2
N_META = 16
D_FF = 2816
CONV_W = 3
HG_HEADS = 8
HG_DK = D_MODEL // HG_HEADS
HG_DV = D_MODEL // HG_HEADS
D_HG = HG_HEADS * HG_DK
CHUNK = 64
EPS = 1e-6
N_CONV_LAYERS = (DEPTH + 1) // 2
N_HGRN_LAYERS = DEPTH // 2

kernel_name = "hybrid_shortconv_hgrn2_macaron_encoder"


def rmsnorm(x, g):
    xf = x.astype(jnp.float32)
    y = xf * lax.rsqrt(jnp.mean(xf * xf, axis=-1, keepdims=True) + EPS)
    return (y * g.astype(jnp.float32)).astype(x.dtype)


def swiglu(x, w_gate, w_up, w_down):
    return (jax.nn.silu(x @ w_gate) * (x @ w_up)) @ w_down


def short_conv_mixer(u, w_in, w_conv, w_out):
    seq_len = u.shape[1]
    gate_b, gate_c, xv = jnp.split(u @ w_in, 3, axis=-1)
    z = gate_c * xv
    zp = jnp.pad(z, ((0, 0), (1, 1), (0, 0)))
    conv = (w_conv[0] * zp[:, :seq_len] + w_conv[1] * zp[:, 1:seq_len + 1]
            + w_conv[2] * zp[:, 2:])
    return (gate_b * conv) @ w_out


def chunk_gla(q, k, v, logf, s0):
    b = jnp.cumsum(logf, axis=3)
    c = q.shape[3]
    lower_tri = jnp.tril(jnp.ones((c, c), dtype=bool))[:, :, None]

    def step(s, inp):
        qc, kc, vc, bc = inp
        o_inter = jnp.einsum('bhtk,bhkv->bhtv', qc * jnp.exp(bc), s)
        diff = bc[:, :, :, None, :] - bc[:, :, None, :, :]
        decay = jnp.exp(jnp.where(lower_tri, diff, -jnp.inf))
        scores = jnp.einsum('bhtk,bhsk,bhtsk->bhts', qc, kc, decay)
        o_intra = jnp.einsum('bhts,bhsv->bhtv', scores, vc)
        b_last = bc[:, :, -1:, :]
        s_new = (jnp.exp(b_last[:, :, 0, :])[..., None] * s
                 + jnp.einsum('bhsk,bhsv->bhkv', kc * jnp.exp(b_last - bc), vc))
        return s_new, o_inter + o_intra

    xs = tuple(jnp.moveaxis(t, 2, 0) for t in (q, k, v, b))
    s_fin, o = lax.scan(step, s0, xs)
    return jnp.moveaxis(o, 0, 2), s_fin


def _segment(t, start, length, c):
    bn, h, _, d = t.shape
    return t[:, :, start:start + length].reshape(bn, h, length // c, c, d)


def directional_scan(q, k, v, logf, segments):
    bn, h, _, dk = q.shape
    dv = v.shape[-1]
    s = jnp.zeros((bn, h, dk, dv), jnp.float32)
    outs = []
    start = 0
    for length, c in segments:
        o, s = chunk_gla(_segment(q, start, length, c), _segment(k, start, length, c),
                         _segment(v, start, length, c), _segment(logf, start, length, c), s)
        outs.append(o.reshape(bn, h, length, dv))
        start += length
    return jnp.concatenate(outs, axis=2)


def hgrn2_mixer(u, w_in, lb, gn, w_out):
    bn, seq_len, _ = u.shape
    n_real = seq_len - N_META
    q, v, z_fwd, z_bwd, g = jnp.split(u @ w_in, 5, axis=-1)

    def heads(t, d):
        return t.reshape(bn, seq_len, HG_HEADS, d).transpose(0, 2, 1, 3).astype(jnp.float32)

    qh = heads(jax.nn.silu(q), HG_DK)
    vh = heads(v, HG_DV)

    def gates(z, lbd):
        zh = heads(z, HG_DK)
        lbd = lbd.astype(jnp.float32).reshape(HG_HEADS, 1, HG_DK)
        logf = jnp.logaddexp(jnp.log(lbd), jnp.log1p(-lbd) + jax.nn.log_sigmoid(zh))
        key = (1.0 - lbd) * jax.nn.sigmoid(-zh)
        return key, logf

    k_f, lf_f = gates(z_fwd, lb[0])
    k_b, lf_b = gates(z_bwd, lb[1])
    o_fwd = directional_scan(qh, k_f, vh, lf_f, [(N_META, N_META), (n_real, CHUNK)])
    flip = lambda t: jnp.flip(t, axis=2)
    o_bwd = flip(directional_scan(flip(qh), flip(k_b), flip(vh), flip(lf_b),
                                  [(n_real, CHUNK), (N_META, N_META)]))
    o = (o_fwd + o_bwd).transpose(0, 2, 1, 3)
    gated = o * jax.nn.silu(g.astype(jnp.float32)).reshape(bn, seq_len, HG_HEADS, HG_DV)
    normed = gated * lax.rsqrt(jnp.mean(gated * gated, axis=-1, keepdims=True) + EPS)
    normed = normed * gn.astype(jnp.float32).reshape(HG_HEADS, HG_DV)
    return normed.reshape(bn, seq_len, D_HG).astype(u.dtype) @ w_out


def trunk(x, meta_tokens, norm_pre, norm_post, ffn_w_gate, ffn_w_up, ffn_w_down,
          sc_w_in, sc_conv, sc_w_out, hg_w_in, hg_lb_logits, hg_gn, hg_w_out, final_norm):
    bn = x.shape[0]
    meta = jnp.broadcast_to(meta_tokens.astype(x.dtype)[None], (bn, N_META, D_MODEL))
    h = jnp.concatenate([meta, x], axis=1)
    p = jax.nn.softmax(hg_lb_logits.astype(jnp.float32), axis=0)
    cs = jnp.cumsum(p, axis=0)
    lower_bounds = cs - cs[0:1]
    for i in range(DEPTH):
        f1 = swiglu(rmsnorm(h, norm_pre[i, 0]), ffn_w_gate[i, 0], ffn_w_up[i, 0], ffn_w_down[i, 0])
        h = h + 0.5 * rmsnorm(f1, norm_post[i, 0])
        u = rmsnorm(h, norm_pre[i, 1])
        j = i // N_MIXERS
        if i % N_MIXERS == 0:
            m = short_conv_mixer(u, sc_w_in[j], sc_conv[j], sc_w_out[j])
        else:
            m = hgrn2_mixer(u, hg_w_in[j], lower_bounds[i], hg_gn[j], hg_w_out[j])
        h = h + rmsnorm(m, norm_post[i, 1])
        f2 = swiglu(rmsnorm(h, norm_pre[i, 2]), ffn_w_gate[i, 1], ffn_w_up[i, 1], ffn_w_down[i, 1])
        h = h + 0.5 * rmsnorm(f2, norm_post[i, 2])
    h = rmsnorm(h, final_norm)
    return h[:, N_META:]


def setup_inputs(seed: int = 0) -> dict:
    key = jax.random.key(seed)
    ks = jax.random.split(key, 16)
    f32 = jnp.float32
    d = D_MODEL
    nrm = lambda k, shape, scale: jax.random.normal(k, shape, f32) * scale
    return {
        "x_prompt": nrm(ks[0], (BATCH, SEQ, d), 1.0),
        "x_sample": nrm(ks[1], (DEC_BATCH, DEC_SEQ, d), 1.0),
        "meta_tokens": nrm(ks[2], (N_META, d), 1.0),
        "norm_pre": 1.0 + nrm(ks[3], (DEPTH, 3, d), 0.02),
        "norm_post": 1.0 + nrm(ks[4], (DEPTH, 3, d), 0.02),
        "ffn_w_gate": nrm(ks[5], (DEPTH, 2, d, D_FF), d ** -0.5),
        "ffn_w_up": nrm(ks[6], (DEPTH, 2, d, D_FF), d ** -0.5),
        "ffn_w_down": nrm(ks[7], (DEPTH, 2, D_FF, d), D_FF ** -0.5),
        "sc_w_in": nrm(ks[8], (N_CONV_LAYERS, d, 3 * d), d ** -0.5),
        "sc_conv": nrm(ks[9], (N_CONV_LAYERS, CONV_W, d), CONV_W ** -0.5),
        "sc_w_out": nrm(ks[10], (N_CONV_LAYERS, d, d), d ** -0.5),
        "hg_w_in": nrm(ks[11], (N_HGRN_LAYERS, d, 5 * D_HG), d ** -0.5),
        "hg_lb_logits": nrm(ks[12], (DEPTH, 2, D_HG), 0.5),
        "hg_gn": 1.0 + nrm(ks[13], (N_HGRN_LAYERS, D_HG), 0.02),
        "hg_w_out": nrm(ks[14], (N_HGRN_LAYERS, D_HG, d), D_HG ** -0.5),
        "final_norm": 1.0 + nrm(ks[15], (d,), 0.02),
    }


def reference(x_prompt, x_sample, meta_tokens, norm_pre, norm_post, ffn_w_gate, ffn_w_up,
              ffn_w_down, sc_w_in, sc_conv, sc_w_out, hg_w_in, hg_lb_logits, hg_gn, hg_w_out,
              final_norm):
    y_prompt = trunk(x_prompt, meta_tokens, norm_pre, norm_post, ffn_w_gate, ffn_w_up, ffn_w_down,
                     sc_w_in, sc_conv, sc_w_out, hg_w_in, hg_lb_logits, hg_gn, hg_w_out, final_norm)
    y_sample = trunk(x_sample, meta_tokens, norm_pre, norm_post, ffn_w_gate, ffn_w_up, ffn_w_down,
                     sc_w_in, sc_conv, sc_w_out, hg_w_in, hg_lb_logits, hg_gn, hg_w_out, final_norm)
    return (y_prompt, y_sample)
```

```cpp
#include <hip/hip_runtime.h>
#include <hip/hip_cooperative_groups.h>
#include <cstdio>
namespace cg = cooperative_groups;

__device__ __forceinline__ int otid() { int t = threadIdx.x; asm volatile("" : "+v"(t)); return t; }
__device__ __forceinline__ int obid() { int t = blockIdx.x; asm volatile("" : "+s"(t)); return t; }
__device__ __forceinline__ int ogdim() { int t = gridDim.x; asm volatile("" : "+s"(t)); return t; }
namespace pg8 {
#define PG8_LAS __attribute__((address_space(3)))
typedef unsigned short bf16_t;
typedef short bf16x8 __attribute__((ext_vector_type(8)));
typedef float f32x4 __attribute__((ext_vector_type(4)));
typedef unsigned u32x4 __attribute__((ext_vector_type(4)));
constexpr int BM = 256, BK = 64, HALF = 128, HTB = HALF * BK * 2  , STAGE_BYTES = 8 * HTB, NXCD = 8, WGM = 8;

__host__ __device__ __forceinline__ int lds_byte(int r, int c) { const int st = (r >> 4) * 2 + (c >> 5), rr = r & 15, cc = c & 31, ob = rr * 64 + cc * 2; return st * 1024 + (ob ^ (((ob >> 9) & 1) << 5)); }
__host__ __device__ __forceinline__ void stage_rc(int b, int& R, int& C) { const int st = b / 1024, sb = b % 1024, swz = sb ^ (((sb >> 9) & 1) << 5); R = (st >> 1) * 16 + swz / 64; C = (st & 1) * 32 + (swz % 64) / 2; }
__host__ __device__ __forceinline__ int perm32(int rho) { const int n = rho >> 4, i = rho & 15; return 8 * (i >> 2) + 4 * n + (i & 3); }

struct Unit { int pm, pn; };
struct Gemm { const bf16_t* A; const bf16_t* Bt; int M, N, K; };

struct StaticOrder {
    int nM, nN, nwg, G, c;
    __host__ __device__ void init(int M, int N, int G_, int c_) { nM = M / BM; nN = N / BM; nwg = nM * nN; G = G_; c = c_; }
    __host__ __device__ bool next(int i, Unit& u) const {
        const long L = (long)i * G + c; if (L >= nwg) return false;
        int wgid = (int)L; { const int q = nwg / NXCD, r = nwg % NXCD, xcd = wgid % NXCD, off = wgid / NXCD; wgid = (xcd < r ? xcd * (q + 1) : r * (q + 1) + (xcd - r) * q) + off; }
        const int nig = WGM * nN, gid = wgid / nig, fm = gid * WGM, gsz = (nM - fm) < WGM ? (nM - fm) : WGM;
        u.pm = fm + ((wgid % nig) % gsz); u.pn = (wgid % nig) / gsz; return true;
    }
    __device__ __forceinline__ void a_ready(const Unit&) const {}
    __device__ __forceinline__ void done(const Unit&) const {}
};
__device__ __forceinline__ unsigned cvt_pk_bf16(float lo, float hi) { unsigned r; asm volatile("v_cvt_pk_bf16_f32 %0, %1, %2" : "=v"(r) : "v"(lo), "v"(hi)); return r; }
template <class Epi, class Sched, bool ALIGN_EPI = false, bool SP2 = false>
__device__ __forceinline__ void gemm_phase(PG8_LAS unsigned char* lds, const Gemm g, const Sched& S, const Epi& E) {
    const int tid = otid(), wid = __builtin_amdgcn_readfirstlane(tid >> 6), lane = tid & 63, wr = wid >> 2, wc = wid & 3, fr = lane & 15, fq = lane >> 4;
    const int K = g.K, nt = K / BK;
    unsigned voffA[2], voffB[2];
#pragma unroll
    for (int i = 0; i < 2; ++i) { int R, C; stage_rc(tid * 16 + i * 8192, R, C); const int Rb = Epi::PERM ? ((R & ~31) + perm32(R & 31)) : R;
        voffA[i] = (unsigned)(R * K + C) * 2u; voffB[i] = (unsigned)(Rb * K + C) * 2u; }
    const size_t kstep = (size_t)(BK * 2);
    const size_t hstep = (size_t)HALF * K * 2;
    const size_t tstep = 2 * hstep;
    const unsigned ldsw = (unsigned)wid * 1024u;
    const int aoff = lds_byte(wr * 64 + fr, fq * 8), boff = lds_byte(wc * 32 + fr, fq * 8);
#define PG8_SA(b, h) (((b) * 2 + (h)) * HTB)
#define PG8_SB(b, h) ((4 + (b) * 2 + (h)) * HTB)
#define PG8_STAGE(bufoff, gbase, voff) do { _Pragma("unroll") for (int _i = 0; _i < 2; ++_i) \
        __builtin_amdgcn_global_load_lds((const unsigned*)((const char*)(gbase) + (voff)[_i]), (PG8_LAS unsigned*)(lds + (bufoff) + ldsw + _i * 8192), 16, 0, 0); } while (0)
#define PG8_LDA(dst, b, h) do { _Pragma("unroll") for (int m = 0; m < 4; ++m) _Pragma("unroll") for (int k = 0; k < 2; ++k) dst[m][k] = *(const PG8_LAS bf16x8*)(lds + PG8_SA(b, h) + aoff + m * 2048 + k * 1024); } while (0)
#define PG8_LDB(dst, b, h) do { _Pragma("unroll") for (int n = 0; n < 2; ++n) _Pragma("unroll") for (int k = 0; k < 2; ++k) dst[n][k] = *(const PG8_LAS bf16x8*)(lds + PG8_SB(b, h) + boff + n * 2048 + k * 1024); } while (0)
#define PG8_MMA(ai, bj, At, Bt) do { __builtin_amdgcn_s_setprio(1); _Pragma("unroll") for (int m = 0; m < 4; ++m) _Pragma("unroll") for (int n = 0; n < 2; ++n) _Pragma("unroll") for (int k = 0; k < 2; ++k) \
        acc[ai][bj][m][n] = __builtin_amdgcn_mfma_f32_16x16x32_bf16(Bt[n][k], At[m][k], acc[ai][bj][m][n], 0, 0, 0); __builtin_amdgcn_s_setprio(0); } while (0)
#define PG8_WAIT_V(n) asm volatile("s_waitcnt vmcnt(" #n ")" ::: "memory")
#define PG8_WAIT_L(n) asm volatile("s_waitcnt lgkmcnt(" #n ")" ::: "memory")
#define PG8_BAR __builtin_amdgcn_s_barrier()
#define PG8_SCHED __builtin_amdgcn_sched_barrier(0)
    Unit cur, nxt; int ui = 0;
    if (!S.next(0, cur)) return;
    f32x4 acc[2][2][4][2];
#pragma unroll
    for (int a = 0; a < 2; ++a)
#pragma unroll
        for (int b = 0; b < 2; ++b)
#pragma unroll
            for (int m = 0; m < 4; ++m)
#pragma unroll
                for (int n = 0; n < 2; ++n) acc[a][b][m][n] = (f32x4){0.f, 0.f, 0.f, 0.f};
    bf16x8 At[4][2], B0[2][2], B1[2][2];
    const char* cA = (const char*)g.A + (size_t)cur.pm * tstep; const char* cB = (const char*)g.Bt + (size_t)cur.pn * tstep;
    S.a_ready(cur);
    if constexpr (SP2) {
        PG8_STAGE(PG8_SB(0, 0), cB, voffB); PG8_STAGE(PG8_SB(0, 1), cB + hstep, voffB); PG8_STAGE(PG8_SA(0, 0), cA, voffA); PG8_STAGE(PG8_SA(0, 1), cA + hstep, voffA);
        if (wr == 1) PG8_BAR;
        PG8_WAIT_V(2); PG8_BAR;
        PG8_STAGE(PG8_SB(1, 0), cB + kstep, voffB); PG8_STAGE(PG8_SA(1, 0), cA + kstep, voffA); PG8_STAGE(PG8_SB(1, 1), cB + hstep + kstep, voffB);
        PG8_WAIT_V(6); PG8_BAR;
    } else {
        PG8_STAGE(PG8_SB(0, 0), cB, voffB); PG8_STAGE(PG8_SA(0, 0), cA, voffA); PG8_STAGE(PG8_SB(0, 1), cB + hstep, voffB); PG8_STAGE(PG8_SA(0, 1), cA + hstep, voffA);
        if (wr == 1) PG8_BAR;
        PG8_WAIT_V(4); PG8_BAR;
        PG8_STAGE(PG8_SB(1, 0), cB + kstep, voffB); PG8_STAGE(PG8_SA(1, 0), cA + kstep, voffA); PG8_STAGE(PG8_SB(1, 1), cB + hstep + kstep, voffB);
        PG8_WAIT_V(6); PG8_BAR;
    }
    for (;;) {
        const bool has_next = S.next(ui + 1, nxt);
        const char* nA = has_next ? (const char*)g.A + (size_t)nxt.pm * tstep : cA; const char* nB = has_next ? (const char*)g.Bt + (size_t)nxt.pn * tstep : cB;
        for (int t = 0; t < nt; t += 2) {
            const bool last = (t == nt - 2);
            const char* a1 = cA + (size_t)(t + 1) * kstep;
            const char* a2 = last ? nA : cA + (size_t)(t + 2) * kstep; const char* b2 = last ? nB : cB + (size_t)(t + 2) * kstep;
            const char* a3 = a2 + kstep; const char* b3 = b2 + kstep;
            if (last && has_next) S.a_ready(nxt);
            if constexpr (SP2) {
            PG8_LDB(B0, 0, 0); PG8_LDB(B1, 0, 1); PG8_SCHED; PG8_LDA(At, 0, 0); PG8_STAGE(PG8_SA(1, 1), a1 + hstep, voffA);
            PG8_WAIT_V(8); PG8_WAIT_L(0); PG8_BAR; PG8_MMA(0, 0, At, B0); PG8_MMA(0, 1, At, B1); PG8_BAR; PG8_SCHED;
            PG8_LDA(At, 0, 1); PG8_STAGE(PG8_SB(0, 0), b2, voffB); PG8_STAGE(PG8_SB(0, 1), b2 + hstep, voffB); PG8_STAGE(PG8_SA(0, 0), a2, voffA);
            PG8_WAIT_V(8); PG8_WAIT_L(0); PG8_BAR; PG8_MMA(1, 0, At, B0); PG8_MMA(1, 1, At, B1); PG8_BAR; PG8_SCHED;
            PG8_LDB(B0, 1, 0); PG8_LDB(B1, 1, 1); PG8_SCHED; PG8_LDA(At, 1, 0); PG8_STAGE(PG8_SA(0, 1), a2 + hstep, voffA);
            PG8_WAIT_V(8); PG8_WAIT_L(0); PG8_BAR; PG8_MMA(0, 0, At, B0); PG8_MMA(0, 1, At, B1); PG8_BAR; PG8_SCHED;
            PG8_LDA(At, 1, 1); PG8_STAGE(PG8_SB(1, 0), b3, voffB); PG8_STAGE(PG8_SB(1, 1), b3 + hstep, voffB); PG8_STAGE(PG8_SA(1, 0), a3, voffA);
            PG8_WAIT_V(8); PG8_WAIT_L(0); PG8_BAR; PG8_MMA(1, 0, At, B0); PG8_MMA(1, 1, At, B1); PG8_BAR; PG8_SCHED;
            } else {
            PG8_LDB(B0, 0, 0); PG8_SCHED; PG8_LDA(At, 0, 0); PG8_STAGE(PG8_SA(1, 1), a1 + hstep, voffA);
            PG8_WAIT_L(8); PG8_BAR; PG8_WAIT_L(0); PG8_MMA(0, 0, At, B0); PG8_BAR; PG8_SCHED;
            PG8_LDB(B1, 0, 1); PG8_STAGE(PG8_SB(0, 0), b2, voffB);
            PG8_BAR; PG8_WAIT_L(0); PG8_MMA(0, 1, At, B1); PG8_BAR;
            PG8_LDA(At, 0, 1); PG8_STAGE(PG8_SA(0, 0), a2, voffA);
            PG8_BAR; PG8_WAIT_L(0); PG8_MMA(1, 0, At, B0); PG8_BAR; PG8_SCHED;
            PG8_STAGE(PG8_SB(0, 1), b2 + hstep, voffB);
            PG8_WAIT_V(6); PG8_BAR; PG8_MMA(1, 1, At, B1); PG8_BAR;
            PG8_LDB(B0, 1, 0); PG8_SCHED; PG8_LDA(At, 1, 0); PG8_STAGE(PG8_SA(0, 1), a2 + hstep, voffA);
            PG8_WAIT_L(8); PG8_BAR; PG8_WAIT_L(0); PG8_MMA(0, 0, At, B0); PG8_BAR; PG8_SCHED;
            PG8_LDB(B1, 1, 1); PG8_STAGE(PG8_SB(1, 0), b3, voffB);
            PG8_BAR; PG8_WAIT_L(0); PG8_MMA(0, 1, At, B1); PG8_BAR;
            PG8_LDA(At, 1, 1); PG8_STAGE(PG8_SA(1, 0), a3, voffA);
            PG8_BAR; PG8_WAIT_L(0); PG8_MMA(1, 0, At, B0); PG8_BAR; PG8_SCHED;
            PG8_STAGE(PG8_SB(1, 1), b3 + hstep, voffB);
            PG8_WAIT_V(6); PG8_BAR; PG8_MMA(1, 1, At, B1); PG8_BAR;
            }
        }
        if constexpr (ALIGN_EPI) { if (wr == 0) PG8_BAR; }
        if constexpr (!Epi::AFTER_DRAIN) { E(acc, cur, wr, wc, fr, fq); S.done(cur); }
        if (!has_next) break;
#pragma unroll
        for (int a = 0; a < 2; ++a)
#pragma unroll
            for (int b = 0; b < 2; ++b)
#pragma unroll
                for (int m = 0; m < 4; ++m)
#pragma unroll
                    for (int n = 0; n < 2; ++n) acc[a][b][m][n] = (f32x4){0.f, 0.f, 0.f, 0.f};
        cur = nxt; cA = nA; cB = nB; ++ui;
        if constexpr (ALIGN_EPI) { if (wr == 1) PG8_BAR; }
    }
    PG8_WAIT_V(0);
    if constexpr (!ALIGN_EPI) { if (wr == 0) PG8_BAR; }
    PG8_BAR;
    if constexpr (Epi::AFTER_DRAIN) { E.fused(acc, cur, wr, wc, fr, fq, lds, wid, lane); S.done(cur); }
#undef PG8_SA
#undef PG8_SB
#undef PG8_STAGE
#undef PG8_LDA
#undef PG8_LDB
#undef PG8_MMA
#undef PG8_WAIT_V
#undef PG8_WAIT_L
#undef PG8_BAR
#undef PG8_SCHED
}
}

typedef unsigned short u16;
typedef long long i64;
constexpr float FIXS = 1048576.0f, FIXI = 1.0f / 1048576.0f;
typedef _Float16 f16;
typedef _Float16 f16x2 __attribute__((ext_vector_type(2)));
using pg8::bf16x8; using pg8::f32x4; using pg8::u32x4;
typedef unsigned u32x2 __attribute__((ext_vector_type(2)));
#define LAS __attribute__((address_space(3)))

constexpr int D = 1024, DFF = 2816;
constexpr int LS = 2064, LL = 16400, SS = 2048, SL = 16384;
constexpr int MTOK = 8 * LS + 2 * LL;
constexpr int MPAD = 49408;
constexpr int NPROW = 8 * LS;
constexpr float EPS = 1e-6f;
constexpr int G_SPLIT = 48896;
constexpr int LDS_BYTES = 131072 + 16;

constexpr size_t SZ_ROWS = (size_t)MPAD * D * 2;
constexpr size_t OFF_W1 = 0;
constexpr size_t OFF_HB = 47185920;
constexpr size_t OFF_RS = OFF_HB + SZ_ROWS;
constexpr size_t OFF_SSQ = OFF_RS + (size_t)MPAD * 4;
constexpr size_t OFF_ACT = OFF_SSQ + (size_t)16 * MPAD * 4;
constexpr size_t OFF_FF = OFF_ACT + (size_t)MPAD * DFF * 2;
constexpr size_t OFF_END = OFF_FF + SZ_ROWS;
constexpr size_t OFF_W0 = OFF_END - 42991616;
constexpr size_t OFF_LB = OFF_END;
constexpr size_t OFF_DL = OFF_END + 8192;
constexpr size_t OFF_ST = OFF_ACT + 2 * SZ_ROWS;
constexpr size_t OFF_BAR = OFF_DL + (size_t)1536 * 128 * 4;
constexpr size_t OFF_SQ1 = OFF_BAR + 16384;
constexpr size_t OFF_SQA = OFF_SQ1 + (size_t)MPAD * 8;
constexpr size_t OFF_SQB = OFF_SQA + (size_t)MPAD * 8;
constexpr size_t OFF_CNT = OFF_SQB + (size_t)MPAD * 8;
constexpr size_t OFF_SQ1L = OFF_CNT + (size_t)193 * 256;
constexpr size_t OFF_CNTL = OFF_SQ1L + 2048;
constexpr size_t OFF_DONE = OFF_CNTL + 256;
constexpr size_t WS_NEED = OFF_DONE + 256;
constexpr size_t WE_GU0 = 0, WE_DN0 = 5767168, WE_GU1 = 8650752, WE_DN1 = 14417920, WE_MIXIN = 17301504;
constexpr size_t WE_SCOUT = WE_MIXIN + 3145728, WE_HGOUT = WE_MIXIN + 5242880;

struct Params { const float* in[16]; float* out; unsigned char* ws; int ph_lo, ph_hi; };

__device__ __forceinline__ float bf2f(u16 b) { return __uint_as_float(((unsigned)b) << 16); }
__device__ __forceinline__ u16 f2bf(float f) { unsigned u = __float_as_uint(f); u += 0x7FFFu + ((u >> 16) & 1u); return (u16)(u >> 16); }
__device__ __forceinline__ unsigned pk_bf(float a, float b) { return pg8::cvt_pk_bf16(a, b); }
__device__ __forceinline__ unsigned pk_h(float a, float b) { f16x2 h = {(f16)a, (f16)b}; return __builtin_bit_cast(unsigned, h); }
__device__ __forceinline__ float h2f(u16 b) { return (float)__builtin_bit_cast(f16, b); }
__device__ __forceinline__ float silu_f(float x) { return x * __builtin_amdgcn_rcpf(1.0f + __expf(-x)); }
__device__ __forceinline__ float wave_sum(float v) {
#pragma unroll
    for (int o = 1; o < 64; o <<= 1) v += __shfl_xor(v, o);
    return v;
}
__device__ __forceinline__ void row_decode(int row, int& s, int& t, int& L) {
    if (row < NPROW) { s = row / LS; t = row - s * LS; L = LS; }
    else { const int r2 = row - NPROW; const int q = r2 / LL; s = 8 + q; t = r2 - q * LL; L = LL; }
}
__device__ __forceinline__ int seq_base(int s) { return s < 8 ? s * LS : NPROW + (s - 8) * LL; }

__device__ __forceinline__ void unpack8(const u32x4 w, float (&o)[8]) {
    o[0] = __uint_as_float(w.x << 16); o[1] = __uint_as_float(w.x & 0xffff0000u); o[2] = __uint_as_float(w.y << 16); o[3] = __uint_as_float(w.y & 0xffff0000u);
    o[4] = __uint_as_float(w.z << 16); o[5] = __uint_as_float(w.z & 0xffff0000u); o[6] = __uint_as_float(w.w << 16); o[7] = __uint_as_float(w.w & 0xffff0000u);
}
__device__ __forceinline__ u32x4 pack8(const float (&o)[8]) { u32x4 w; w.x = pk_bf(o[0], o[1]); w.y = pk_bf(o[2], o[3]); w.z = pk_bf(o[4], o[5]); w.w = pk_bf(o[6], o[7]); return w; }


template <int MODE> struct Epi {
    static constexpr bool PERM = true, AFTER_DRAIN = false;
    const i64* rs; u16* o0; u16* o1; u16* o2; u16* o3; float* ssq; const float* lb;
    __device__ __forceinline__ void operator()(const f32x4 (&acc)[2][2][4][2], const pg8::Unit& u, int wr, int wc, int fr, int fq) const {
        const int row0 = u.pm * 256 + wr * 64 + fr;
        const int cw = wc * 32 + 8 * fq;
        float sc[2][4];
        if (MODE != 1) {
            i64 raw[2][4];
#pragma unroll
            for (int ai = 0; ai < 2; ++ai)
#pragma unroll
                for (int m = 0; m < 4; ++m) raw[ai][m] = rs[row0 + ai * 128 + m * 16];
#pragma unroll
            for (int ai = 0; ai < 2; ++ai)
#pragma unroll
                for (int m = 0; m < 4; ++m) sc[ai][m] = rsqrtf((float)raw[ai][m] * (FIXI / D) + EPS);
        }
        float oml[2][8];
        if (MODE == 3) {
            const int part3 = u.pn >> 2;
#pragma unroll
            for (int bj = 0; bj < 2; ++bj) {
                f32x4 l0 = {0.f, 0.f, 0.f, 0.f}, l1 = {0.f, 0.f, 0.f, 0.f};
                if (part3 >= 2) { const float* lbp = lb + (part3 - 2) * D + (u.pn & 3) * 256 + bj * 128 + cw; l0 = *(const f32x4*)lbp; l1 = *(const f32x4*)(lbp + 4); }
                oml[bj][0] = 1.0f - l0[0]; oml[bj][1] = 1.0f - l0[1]; oml[bj][2] = 1.0f - l0[2]; oml[bj][3] = 1.0f - l0[3];
                oml[bj][4] = 1.0f - l1[0]; oml[bj][5] = 1.0f - l1[1]; oml[bj][6] = 1.0f - l1[2]; oml[bj][7] = 1.0f - l1[3];
            }
        }
#pragma unroll
        for (int ai = 0; ai < 2; ++ai)
#pragma unroll
            for (int m = 0; m < 4; ++m) {
                const int row = row0 + ai * 128 + m * 16;
                if (MODE == 0) {
                    typedef float f2 __attribute__((ext_vector_type(2)));
                    const float s = sc[ai][m]; const float c1 = -1.44269504f * s, s2 = s * s;
                    unsigned wv[4];
#pragma unroll
                    for (int n = 0; n < 2; ++n)
#pragma unroll
                        for (int jp = 0; jp < 2; ++jp) {
                            const f2 ag = {acc[ai][0][m][n][2 * jp], acc[ai][0][m][n][2 * jp + 1]}, au = {acc[ai][1][m][n][2 * jp], acc[ai][1][m][n][2 * jp + 1]};
                            const f2 t = ag * c1; f2 e; e.x = __builtin_amdgcn_exp2f(t.x); e.y = __builtin_amdgcn_exp2f(t.y);
                            const f2 d = e + 1.0f; f2 r; r.x = __builtin_amdgcn_rcpf(d.x); r.y = __builtin_amdgcn_rcpf(d.y);
                            const f2 o = (ag * au) * (r * s2);
                            wv[n * 2 + jp] = pk_bf(o.x, o.y);
                        }
                    u32x4 w; w.x = wv[0]; w.y = wv[1]; w.z = wv[2]; w.w = wv[3];
                    *(u32x4*)(o0 + (size_t)row * DFF + u.pn * 128 + cw) = w;
                } else if (MODE == 1) {
                    float ss = 0.f;
#pragma unroll
                    for (int bj = 0; bj < 2; ++bj) {
                        const f32x4 v0 = acc[ai][bj][m][0], v1 = acc[ai][bj][m][1];
                        ss += v0[0] * v0[0] + v0[1] * v0[1] + v0[2] * v0[2] + v0[3] * v0[3] + v1[0] * v1[0] + v1[1] * v1[1] + v1[2] * v1[2] + v1[3] * v1[3];
                        u32x4 w; w.x = pk_bf(v0[0], v0[1]); w.y = pk_bf(v0[2], v0[3]); w.z = pk_bf(v1[0], v1[1]); w.w = pk_bf(v1[2], v1[3]);
                        *(u32x4*)(o0 + (size_t)row * D + u.pn * 256 + bj * 128 + cw) = w;
                    }
                    ss += __shfl_xor(ss, 16); ss += __shfl_xor(ss, 32);
                    if (fq == 0) ssq[(size_t)(u.pn * 4 + wc) * MPAD + row] = ss;
                } else if (MODE == 2) {
                    const float s = sc[ai][m];
                    if (u.pn < 4) {
#pragma unroll
                        for (int bj = 0; bj < 2; ++bj) {
                            const f32x4 v0 = acc[ai][bj][m][0] * s, v1 = acc[ai][bj][m][1] * s;
                            u32x4 w; w.x = pk_bf(v0[0], v0[1]); w.y = pk_bf(v0[2], v0[3]); w.z = pk_bf(v1[0], v1[1]); w.w = pk_bf(v1[2], v1[3]);
                            *(u32x4*)(o0 + (size_t)row * D + u.pn * 256 + bj * 128 + cw) = w;
                        }
                    } else {
                        const float s2 = s * s;
                        const f32x4 v0 = acc[ai][0][m][0] * acc[ai][1][m][0] * s2, v1 = acc[ai][0][m][1] * acc[ai][1][m][1] * s2;
                        u32x4 w; w.x = pk_bf(v0[0], v0[1]); w.y = pk_bf(v0[2], v0[3]); w.z = pk_bf(v1[0], v1[1]); w.w = pk_bf(v1[2], v1[3]);
                        *(u32x4*)(o1 + (size_t)row * D + (u.pn - 4) * 128 + cw) = w;
                    }
                } else if (MODE == 3) {
                    const float s = sc[ai][m];
                    const int part = u.pn >> 2;
#pragma unroll
                    for (int bj = 0; bj < 2; ++bj) {
                        const int c = (u.pn & 3) * 256 + bj * 128 + cw;
                        const f32x4 v0 = acc[ai][bj][m][0] * s, v1 = acc[ai][bj][m][1] * s;
                        float x[8] = {v0[0], v0[1], v0[2], v0[3], v1[0], v1[1], v1[2], v1[3]};
                        u32x4 w;
                        if (part == 0) {
#pragma unroll
                            for (int e = 0; e < 8; ++e) x[e] = silu_f(x[e]);
                            w.x = pk_bf(x[0], x[1]); w.y = pk_bf(x[2], x[3]); w.z = pk_bf(x[4], x[5]); w.w = pk_bf(x[6], x[7]);
                            *(u32x4*)(o0 + (size_t)row * D + c) = w;
                        } else if (part == 1) {
                            w.x = pk_bf(x[0], x[1]); w.y = pk_bf(x[2], x[3]); w.z = pk_bf(x[4], x[5]); w.w = pk_bf(x[6], x[7]);
                            *(u32x4*)(o1 + (size_t)row * D + c) = w;
                        } else {
#pragma unroll
                            for (int e = 0; e < 8; ++e) x[e] = oml[bj][e] * __builtin_amdgcn_rcpf(1.0f + __expf(x[e]));
                            w.x = pk_h(x[0], x[1]); w.y = pk_h(x[2], x[3]); w.z = pk_h(x[4], x[5]); w.w = pk_h(x[6], x[7]);
                            *(u32x4*)((part == 2 ? o2 : o3) + (size_t)row * D + c) = w;
                        }
                    }
                } else {
                    const float s = sc[ai][m];
#pragma unroll
                    for (int bj = 0; bj < 2; ++bj) {
                        const f32x4 v0 = acc[ai][bj][m][0] * s, v1 = acc[ai][bj][m][1] * s;
                        u32x4 w; w.x = pk_bf(silu_f(v0[0]), silu_f(v0[1])); w.y = pk_bf(silu_f(v0[2]), silu_f(v0[3])); w.z = pk_bf(silu_f(v1[0]), silu_f(v1[1])); w.w = pk_bf(silu_f(v1[2]), silu_f(v1[3]));
                        u16* gd = row < G_SPLIT ? o0 + (size_t)row * D : o1 + (size_t)(row - G_SPLIT) * D;
                        *(u32x4*)(gd + u.pn * 256 + bj * 128 + cw) = w;
                    }
                }
            }
    }
};

struct SplitOrder : pg8::StaticOrder {
    int part; int hz; const unsigned* ready;
    __device__ __forceinline__ bool next(int i, pg8::Unit& u) const {
        if (part == 2) { if (i == 0 && c < nN) { u.pm = 192; u.pn = c; return true; } return false; }
        if (part >= 3) {
            const int cp = (c & 7) * (G >> 3) + (c >> 3);
            if (part == 4) { if (i == 0 && cp < 4) { u.pm = 192; u.pn = cp; return true; } return false; }
            const long Lp = (long)i * G + cp; u.pm = (int)(Lp >> 2); u.pn = (int)(Lp & 3); return u.pm < (part == 5 ? 192 : 193); }
        if (part == 0 && ready != nullptr) {
            const int nfull = nwg / G, rem = nwg - nfull * G;
            const int cp = (c & 7) * (G >> 3) + (c >> 3);
            if (cp < 4) { const int mine = nfull + (c < rem ? 1 : 0); if (i >= mine - 3) return false; }
            else { const int k = G - 1 - c;
                if (k < 12 && c >= rem && i == nfull) {
                    const int q = k / 3, cl = q * 8;
                    const int cnt_l = nfull + (cl < rem ? 1 : 0);
                    SplitOrder t = *this; t.c = cl;
                    return t.pg8::StaticOrder::next(cnt_l - 3 + (k - 3 * q), u);
                } }
        }
        return pg8::StaticOrder::next(i, u);
    }
    __device__ __forceinline__ void a_ready(const pg8::Unit& u) const {
        if (ready != nullptr && (u.pm == 192 || (hz && (u.pm == 69 || u.pm == 70)))) {
            if (threadIdx.x < 64) {
                unsigned sp = 0;
                while ((unsigned)__builtin_amdgcn_readfirstlane(__hip_atomic_load(ready, __ATOMIC_RELAXED, __HIP_MEMORY_SCOPE_AGENT)) < 32u) { __builtin_amdgcn_s_sleep(2); if (++sp > (1u << 19)) break; }
                __builtin_amdgcn_fence(__ATOMIC_ACQUIRE, "agent");
                asm volatile("s_waitcnt vmcnt(0)" ::: "memory");
            }
            asm volatile("" ::: "memory"); __builtin_amdgcn_s_barrier(); asm volatile("" ::: "memory");
        }
    }
};
template <int MODE>
__device__ __forceinline__ void run_gemm(unsigned char* lds, const u16* A, const u16* Bt, int N, int K, const Epi<MODE>& E, int part, const unsigned* ready = nullptr, int hz = 0) {
    pg8::Gemm g{A, Bt, MPAD, N, K}; SplitOrder S; S.init(part == 0 ? MPAD : 192 * 256, N, (int)ogdim(), (int)obid()); S.part = part; S.ready = ready; S.hz = hz;
    pg8::gemm_phase<Epi<MODE>, SplitOrder, true, true>((LAS unsigned char*)lds, g, S, E);
}


struct EpiRes {
    static constexpr bool PERM = true, AFTER_DRAIN = false;
    u16* HB; i64* ssq1; i64* ssq2; unsigned* cnt; const float* gpost; float coef; unsigned* done;
    __device__ __forceinline__ void operator()(const f32x4 (&acc)[2][2][4][2], const pg8::Unit& u, int wr, int wc, int fr, int fq) const {
        const int row0 = u.pm * 256 + wr * 64 + fr;
        const int colb = u.pn * 256 + wc * 32 + 8 * fq;
#pragma unroll
        for (int ai = 0; ai < 2; ++ai)
#pragma unroll
            for (int m = 0; m < 4; ++m) {
                float ss = 0.f;
#pragma unroll
                for (int bj = 0; bj < 2; ++bj) { const f32x4 v0 = acc[ai][bj][m][0], v1 = acc[ai][bj][m][1];
                    ss += v0[0] * v0[0] + v0[1] * v0[1] + v0[2] * v0[2] + v0[3] * v0[3] + v1[0] * v1[0] + v1[1] * v1[1] + v1[2] * v1[2] + v1[3] * v1[3]; }
                ss += __shfl_xor(ss, 16); ss += __shfl_xor(ss, 32);
                if (fq == 0) (void)__hip_atomic_fetch_add(ssq1 + row0 + ai * 128 + m * 16, (i64)(ss * FIXS + 0.5f), __ATOMIC_RELAXED, __HIP_MEMORY_SCOPE_AGENT);
            }
        asm volatile("s_waitcnt vmcnt(0)" ::: "memory");
        unsigned* pc = cnt + 64 * u.pm;
        if (fr == 0 && fq == 0) (void)__hip_atomic_fetch_add(pc, 1u, __ATOMIC_RELAXED, __HIP_MEMORY_SCOPE_AGENT);
        u32x4 hraw[4][2];
#pragma unroll
        for (int m = 0; m < 4; ++m)
#pragma unroll
            for (int bj = 0; bj < 2; ++bj) hraw[m][bj] = *(const u32x4*)(HB + (size_t)(row0 + m * 16) * D + colb + bj * 128);
        float g[2][8];
#pragma unroll
        for (int bj = 0; bj < 2; ++bj) { const f32x4 a = *(const f32x4*)(gpost + colb + bj * 128), b = *(const f32x4*)(gpost + colb + bj * 128 + 4);
            g[bj][0] = a[0] * coef; g[bj][1] = a[1] * coef; g[bj][2] = a[2] * coef; g[bj][3] = a[3] * coef; g[bj][4] = b[0] * coef; g[bj][5] = b[1] * coef; g[bj][6] = b[2] * coef; g[bj][7] = b[3] * coef; }
        { unsigned sp = 0;
          while ((unsigned)__builtin_amdgcn_readfirstlane(__hip_atomic_load(pc, __ATOMIC_RELAXED, __HIP_MEMORY_SCOPE_AGENT)) < 32u) { __builtin_amdgcn_s_sleep(2); if (++sp > (1u << 19)) break; } }
        float tot[2][4];
#pragma unroll
        for (int ai = 0; ai < 2; ++ai)
#pragma unroll
            for (int m = 0; m < 4; ++m) tot[ai][m] = (float)__hip_atomic_load(ssq1 + row0 + ai * 128 + m * 16, __ATOMIC_RELAXED, __HIP_MEMORY_SCOPE_AGENT);
#pragma unroll
        for (int ai = 0; ai < 2; ++ai) {
            if (ai == 1) {
#pragma unroll
                for (int m = 0; m < 4; ++m)
#pragma unroll
                    for (int bj = 0; bj < 2; ++bj) hraw[m][bj] = *(const u32x4*)(HB + (size_t)(row0 + 128 + m * 16) * D + colb + bj * 128);
            }
#pragma unroll
            for (int m = 0; m < 4; ++m) {
                const int row = row0 + ai * 128 + m * 16;
                const float rstd = rsqrtf(tot[ai][m] * (FIXI / D) + EPS);
                float s2 = 0.f;
#pragma unroll
                for (int bj = 0; bj < 2; ++bj) {
                    float h[8]; unpack8(hraw[m][bj], h);
                    const f32x4 v0 = acc[ai][bj][m][0], v1 = acc[ai][bj][m][1];
                    h[0] += v0[0] * rstd * g[bj][0]; h[1] += v0[1] * rstd * g[bj][1]; h[2] += v0[2] * rstd * g[bj][2]; h[3] += v0[3] * rstd * g[bj][3];
                    h[4] += v1[0] * rstd * g[bj][4]; h[5] += v1[1] * rstd * g[bj][5]; h[6] += v1[2] * rstd * g[bj][6]; h[7] += v1[3] * rstd * g[bj][7];
#pragma unroll
                    for (int e = 0; e < 8; ++e) s2 += h[e] * h[e];
                    *(u32x4*)(HB + (size_t)row * D + colb + bj * 128) = pack8(h);
                }
                s2 += __shfl_xor(s2, 16); s2 += __shfl_xor(s2, 32);
                if (fq == 0) (void)__hip_atomic_fetch_add(ssq2 + row, (i64)(s2 * FIXS + 0.5f), __ATOMIC_RELAXED, __HIP_MEMORY_SCOPE_AGENT);
            }
            asm volatile("" ::: "memory");
        }
        if (done) {
            __builtin_amdgcn_fence(__ATOMIC_RELEASE, "agent"); asm volatile("s_waitcnt vmcnt(0)" ::: "memory");
            if (fr == 0 && fq == 0) (void)__hip_atomic_fetch_add(done, 1u, __ATOMIC_RELAXED, __HIP_MEMORY_SCOPE_AGENT);
        }
    }
};
__device__ __forceinline__ void run_gemm_res(unsigned char* lds, const u16* A, const u16* Bt, int K, const EpiRes& E, int part) {
    pg8::Gemm g{A, Bt, MPAD, D, K}; SplitOrder S; S.init(MPAD, D, (int)ogdim(), (int)obid()); S.part = part; S.ready = nullptr; S.hz = 0;
    pg8::gemm_phase<EpiRes, SplitOrder, true, true>((LAS unsigned char*)lds, g, S, E);
}

__device__ __forceinline__ void conv_tile(unsigned char* lds, const float* src, int ld, int col0, const float* gain, u16* dst, int K, int n0, int k0) {
    float* tile = (float*)lds;
    const int tid = otid();
#pragma unroll
    for (int i = 0; i < 2; ++i) { const int e = tid + 512 * i, kk = e >> 4, n4 = (e & 15) * 4;
        f32x4 v = *(const f32x4*)(src + (size_t)(k0 + kk) * ld + col0 + n4); if (gain) v = v * gain[k0 + kk];
        tile[kk * 65 + n4] = v[0]; tile[kk * 65 + n4 + 1] = v[1]; tile[kk * 65 + n4 + 2] = v[2]; tile[kk * 65 + n4 + 3] = v[3]; }
    __syncthreads();
    { const int kq = tid & 7, nn = tid >> 3; float o[8];
#pragma unroll
      for (int j = 0; j < 8; ++j) o[j] = tile[(8 * kq + j) * 65 + nn];
      *(u32x4*)(dst + (size_t)(n0 + nn) * K + k0 + 8 * kq) = pack8(o); }
    __syncthreads();
}

__device__ void phase0(const Params& p, unsigned char* lds) {
    unsigned char* ws = p.ws;
    const int tid = otid(), lane = tid & 63, wave = tid >> 6;
    for (int i = obid() * 512 + tid; i < 2048; i += ogdim() * 512) {
        const float l0 = p.in[12][i], l1 = p.in[12][2048 + i];
        ((float*)(ws + OFF_LB))[i] = 1.0f / (1.0f + expf(l0 - l1));
    }
    u16* HB = (u16*)(ws + OFF_HB); i64* RS = (i64*)(ws + OFF_SQA);
    for (int row = obid() * 8 + wave; row < MPAD; row += ogdim() * 8) {
        u32x4 w0 = {0u, 0u, 0u, 0u}, w1 = {0u, 0u, 0u, 0u}; float rsv = 0.f;
        if (row < MTOK) {
            int s, t, L; row_decode(row, s, t, L);
            const float* src = (t < 16) ? p.in[2] + (size_t)t * D : (s < 8 ? p.in[0] + ((size_t)s * SS + (t - 16)) * D : p.in[1] + ((size_t)(s - 8) * SL + (t - 16)) * D);
            const f32x4 a = *(const f32x4*)(src + lane * 16), b = *(const f32x4*)(src + lane * 16 + 4), c = *(const f32x4*)(src + lane * 16 + 8), d = *(const f32x4*)(src + lane * 16 + 12);
            float ss = a[0] * a[0] + a[1] * a[1] + a[2] * a[2] + a[3] * a[3] + b[0] * b[0] + b[1] * b[1] + b[2] * b[2] + b[3] * b[3]
                     + c[0] * c[0] + c[1] * c[1] + c[2] * c[2] + c[3] * c[3] + d[0] * d[0] + d[1] * d[1] + d[2] * d[2] + d[3] * d[3];
            ss = wave_sum(ss); rsv = ss;
            w0.x = pk_bf(a[0], a[1]); w0.y = pk_bf(a[2], a[3]); w0.z = pk_bf(b[0], b[1]); w0.w = pk_bf(b[2], b[3]);
            w1.x = pk_bf(c[0], c[1]); w1.y = pk_bf(c[2], c[3]); w1.z = pk_bf(d[0], d[1]); w1.w = pk_bf(d[2], d[3]);
        }
        *(u32x4*)(HB + (size_t)row * D + lane * 16) = w0; *(u32x4*)(HB + (size_t)row * D + lane * 16 + 8) = w1;
        if (lane == 0) RS[row] = (i64)(rsv * FIXS + 0.5f);
    }
    for (int job = obid(); job < 11008; job += ogdim()) {
        int idx = job; const float* src; int ld, col0, K, n0, k0; const float* gain = nullptr; u16* dst;
        if (idx < 8448) {
            const int lf = idx / 2112, l = lf >> 1, f = lf & 1; int r = idx - lf * 2112;
            u16* wl = (u16*)(ws + (l ? OFF_W1 : OFF_W0));
            if (r < 1408) { const int nt = r >> 4, kt = r & 15; n0 = nt * 64; k0 = kt * 64; K = D; ld = DFF;
                const int t256 = n0 >> 8, within = n0 & 255;
                if (within < 128) { src = p.in[5] + (size_t)lf * D * DFF; col0 = t256 * 128 + within; } else { src = p.in[6] + (size_t)lf * D * DFF; col0 = t256 * 128 + within - 128; }
                gain = p.in[3] + (l * 3 + (f ? 2 : 0)) * D; dst = wl + (f ? WE_GU1 : WE_GU0);
            } else { r -= 1408; const int nt = r / 44, kt = r - nt * 44; n0 = nt * 64; k0 = kt * 64; K = DFF; ld = D; src = p.in[7] + (size_t)lf * DFF * D; col0 = n0; dst = wl + (f ? WE_DN1 : WE_DN0); }
        } else {
            idx -= 8448;
            if (idx < 768) { const int nt = idx >> 4, kt = idx & 15; n0 = nt * 64; k0 = kt * 64; K = D; ld = 3 * D; src = p.in[8]; gain = p.in[3] + 1 * D; dst = (u16*)(ws + OFF_W0) + WE_MIXIN;
                if (n0 < 1024) col0 = n0; else { const int t = (n0 - 1024) >> 8, within = (n0 - 1024) & 255; col0 = within < 128 ? 1024 + t * 128 + within : 2048 + t * 128 + within - 128; }
            } else if (idx < 1024) { idx -= 768; const int nt = idx >> 4, kt = idx & 15; n0 = nt * 64; k0 = kt * 64; K = D; ld = D; src = p.in[10]; col0 = n0; dst = (u16*)(ws + OFF_W0) + WE_SCOUT;
            } else if (idx < 2304) { idx -= 1024; const int nt = idx >> 4, kt = idx & 15; n0 = nt * 64; k0 = kt * 64; K = D; ld = 5 * D; src = p.in[11]; col0 = n0; gain = p.in[3] + 4 * D; dst = (u16*)(ws + OFF_W1) + WE_MIXIN;
            } else { idx -= 2304; const int nt = idx >> 4, kt = idx & 15; n0 = nt * 64; k0 = kt * 64; K = D; ld = D; src = p.in[14]; col0 = n0; dst = (u16*)(ws + OFF_W1) + WE_HGOUT; }
        }
        conv_tile(lds, src, ld, col0, gain, dst, K, n0, k0);
    }
}

__device__ void row_update(const u16* F, const float* ssq, const float* gpost, float coef, u16* HB, float* RS, float* out, const float* gfinal, int r_lo, int r_hi, int bidx, int nblk) {
    const int lane = otid() & 63, wave = otid() >> 6;
    float g[16];
#pragma unroll
    for (int q = 0; q < 4; ++q) { const f32x4 gv = *(const f32x4*)(gpost + lane * 16 + q * 4); g[q * 4] = gv[0] * coef; g[q * 4 + 1] = gv[1] * coef; g[q * 4 + 2] = gv[2] * coef; g[q * 4 + 3] = gv[3] * coef; }
    const int nw = nblk * 8;
    f32x4 gfin[4];
#pragma unroll
    for (int q = 0; q < 4; ++q) gfin[q] = out ? *(const f32x4*)(gfinal + lane * 16 + q * 4) : (f32x4){0.f, 0.f, 0.f, 0.f};
    for (int row0 = r_lo + bidx * 8 + wave; row0 < r_hi; row0 += 2 * nw) {
        const int row1 = row0 + nw; const bool has1 = row1 < r_hi; const int r1 = has1 ? row1 : row0;
        float ssa = lane < 16 ? ssq[(size_t)lane * MPAD + row0] : 0.f, ssb = lane < 16 ? ssq[(size_t)lane * MPAD + r1] : 0.f;
        const u32x4 fa0 = *(const u32x4*)(F + (size_t)row0 * D + lane * 16), fa1 = *(const u32x4*)(F + (size_t)row0 * D + lane * 16 + 8);
        const u32x4 fb0 = *(const u32x4*)(F + (size_t)r1 * D + lane * 16), fb1 = *(const u32x4*)(F + (size_t)r1 * D + lane * 16 + 8);
        const u32x4 ha0 = *(const u32x4*)(HB + (size_t)row0 * D + lane * 16), ha1 = *(const u32x4*)(HB + (size_t)row0 * D + lane * 16 + 8);
        const u32x4 hb0 = *(const u32x4*)(HB + (size_t)r1 * D + lane * 16), hb1 = *(const u32x4*)(HB + (size_t)r1 * D + lane * 16 + 8);
#pragma unroll
        for (int o = 1; o < 16; o <<= 1) { ssa += __shfl_xor(ssa, o); ssb += __shfl_xor(ssb, o); }
        ssa = __shfl(ssa, 0); ssb = __shfl(ssb, 0);
        const float rsa = rsqrtf(ssa * (1.0f / D) + EPS), rsb = rsqrtf(ssb * (1.0f / D) + EPS);
        float fa[16], fb[16], ha[16], hb[16];
        unpack8(fa0, *(float(*)[8])&fa[0]); unpack8(fa1, *(float(*)[8])&fa[8]); unpack8(fb0, *(float(*)[8])&fb[0]); unpack8(fb1, *(float(*)[8])&fb[8]);
        unpack8(ha0, *(float(*)[8])&ha[0]); unpack8(ha1, *(float(*)[8])&ha[8]); unpack8(hb0, *(float(*)[8])&hb[0]); unpack8(hb1, *(float(*)[8])&hb[8]);
        float s2a = 0.f, s2b = 0.f;
#pragma unroll
        for (int e = 0; e < 16; ++e) { ha[e] = ha[e] + fa[e] * rsa * g[e]; s2a += ha[e] * ha[e]; hb[e] = hb[e] + fb[e] * rsb * g[e]; s2b += hb[e] * hb[e]; }
#pragma unroll
        for (int o = 1; o < 64; o <<= 1) { s2a += __shfl_xor(s2a, o); s2b += __shfl_xor(s2b, o); }
        const float ra = rsqrtf(s2a * (1.0f / D) + EPS), rb = rsqrtf(s2b * (1.0f / D) + EPS);
        if (!out) {
        *(u32x4*)(HB + (size_t)row0 * D + lane * 16) = pack8(*(float(*)[8])&ha[0]); *(u32x4*)(HB + (size_t)row0 * D + lane * 16 + 8) = pack8(*(float(*)[8])&ha[8]);
        if (lane == 0) RS[row0] = ra;
        }
        if (has1 && !out) { *(u32x4*)(HB + (size_t)row1 * D + lane * 16) = pack8(*(float(*)[8])&hb[0]); *(u32x4*)(HB + (size_t)row1 * D + lane * 16 + 8) = pack8(*(float(*)[8])&hb[8]); if (lane == 0) RS[row1] = rb; }
        if (out) {
#pragma unroll
            for (int rr = 0; rr < 2; ++rr) {
                const int row = rr ? row1 : row0; if (rr && !has1) break;
                int sq, t, L; row_decode(row, sq, t, L);
                if (t >= 16) {
                    const size_t orow = sq < 8 ? (size_t)sq * SS + (t - 16) : (size_t)8 * SS + (size_t)(sq - 8) * SL + (t - 16);
                    const float rr2 = rr ? rb : ra;
#pragma unroll
                    for (int q = 0; q < 4; ++q) { const f32x4 gv = gfin[q];
                        f32x4 o; const float* hh = rr ? hb : ha; o[0] = hh[q * 4] * rr2 * gv[0]; o[1] = hh[q * 4 + 1] * rr2 * gv[1]; o[2] = hh[q * 4 + 2] * rr2 * gv[2]; o[3] = hh[q * 4 + 3] * rr2 * gv[3];
                        *(f32x4*)(out + orow * D + lane * 16 + q * 4) = o; }
                }
            }
        }
    }
}

__device__ void conv_phase(u16* GB, const u16* Z, const float* wconv) {
    const int c = (otid() & 127) * 8;
    float w0[8], w1[8], w2[8];
#pragma unroll
    for (int e = 0; e < 8; ++e) { w0[e] = wconv[c + e]; w1[e] = wconv[D + c + e]; w2[e] = wconv[2 * D + c + e]; }
    const int nrb = MTOK / 8;
    for (int rb = obid() * 4 + (otid() >> 7); rb < nrb; rb += (int)ogdim() * 4) {
        const int r0 = rb * 8;
        int s, t, L; row_decode(r0, s, t, L);
        u32x4 zr[10], gr[8];
        zr[0] = (t > 0) ? *(const u32x4*)(Z + (size_t)(r0 - 1) * D + c) : (u32x4){0u, 0u, 0u, 0u};
#pragma unroll
        for (int i = 0; i < 8; ++i) { zr[i + 1] = *(const u32x4*)(Z + (size_t)(r0 + i) * D + c); gr[i] = *(const u32x4*)(GB + (size_t)(r0 + i) * D + c); }
        zr[9] = (t + 8 < L) ? *(const u32x4*)(Z + (size_t)(r0 + 8) * D + c) : (u32x4){0u, 0u, 0u, 0u};
        float zp[8], zc[8], zn[8];
        unpack8(zr[0], zp); unpack8(zr[1], zc);
#pragma unroll
        for (int i = 0; i < 8; ++i) {
            unpack8(zr[i + 2], zn);
            float gb[8], y[8]; unpack8(gr[i], gb);
#pragma unroll
            for (int e = 0; e < 8; ++e) { y[e] = gb[e] * (w0[e] * zp[e] + w1[e] * zc[e] + w2[e] * zn[e]); zp[e] = zc[e]; zc[e] = zn[e]; }
            *(u32x4*)(GB + (size_t)(r0 + i) * D + c) = pack8(y);
        }
    }
}

__device__ void gate_norm_phase(u16* O, const u16* G0, const u16* G1, const float* gn, int r_lo, int r_hi, int bidx, int nblk) {
    const int lane = otid() & 63, wave = otid() >> 6;
    float gv[16];
#pragma unroll
    for (int q = 0; q < 4; ++q) { const f32x4 a = *(const f32x4*)(gn + lane * 16 + q * 4); gv[q * 4] = a[0]; gv[q * 4 + 1] = a[1]; gv[q * 4 + 2] = a[2]; gv[q * 4 + 3] = a[3]; }
    const int nw = nblk * 8;
    for (int row0 = r_lo + bidx * 8 + wave; row0 < r_hi; row0 += 2 * nw) {
        const int row1 = row0 + nw; const bool has1 = row1 < r_hi; const int r1 = has1 ? row1 : row0;
        const u32x4 oa0 = *(const u32x4*)(O + (size_t)row0 * D + lane * 16), oa1 = *(const u32x4*)(O + (size_t)row0 * D + lane * 16 + 8);
        const u16* Ga = row0 < G_SPLIT ? G0 + (size_t)row0 * D : G1 + (size_t)(row0 - G_SPLIT) * D; const u16* Gb = r1 < G_SPLIT ? G0 + (size_t)r1 * D : G1 + (size_t)(r1 - G_SPLIT) * D;
        const u32x4 ga0 = *(const u32x4*)(Ga + lane * 16), ga1 = *(const u32x4*)(Ga + lane * 16 + 8);
        const u32x4 ob0 = *(const u32x4*)(O + (size_t)r1 * D + lane * 16), ob1 = *(const u32x4*)(O + (size_t)r1 * D + lane * 16 + 8);
        const u32x4 gb0 = *(const u32x4*)(Gb + lane * 16), gb1 = *(const u32x4*)(Gb + lane * 16 + 8);
        float oa[16], ga[16], ob[16], gb[16];
        unpack8(oa0, *(float(*)[8])&oa[0]); unpack8(oa1, *(float(*)[8])&oa[8]); unpack8(ga0, *(float(*)[8])&ga[0]); unpack8(ga1, *(float(*)[8])&ga[8]);
        unpack8(ob0, *(float(*)[8])&ob[0]); unpack8(ob1, *(float(*)[8])&ob[8]); unpack8(gb0, *(float(*)[8])&gb[0]); unpack8(gb1, *(float(*)[8])&gb[8]);
        float sa = 0.f, sb = 0.f;
#pragma unroll
        for (int e = 0; e < 16; ++e) { oa[e] *= ga[e]; sa += oa[e] * oa[e]; ob[e] *= gb[e]; sb += ob[e] * ob[e]; }
        sa += __shfl_xor(sa, 1); sa += __shfl_xor(sa, 2); sa += __shfl_xor(sa, 4);
        sb += __shfl_xor(sb, 1); sb += __shfl_xor(sb, 2); sb += __shfl_xor(sb, 4);
        const float ra = rsqrtf(sa * (1.0f / 128.0f) + EPS), rb = rsqrtf(sb * (1.0f / 128.0f) + EPS);
#pragma unroll
        for (int e = 0; e < 16; ++e) { oa[e] = oa[e] * ra * gv[e]; ob[e] = ob[e] * rb * gv[e]; }
        *(u32x4*)(O + (size_t)row0 * D + lane * 16) = pack8(*(float(*)[8])&oa[0]); *(u32x4*)(O + (size_t)row0 * D + lane * 16 + 8) = pack8(*(float(*)[8])&oa[8]);
        if (has1) { *(u32x4*)(O + (size_t)row1 * D + lane * 16) = pack8(*(float(*)[8])&ob[0]); *(u32x4*)(O + (size_t)row1 * D + lane * 16 + 8) = pack8(*(float(*)[8])&ob[8]); }
    }
}

constexpr int L_QH = 0, L_KH = 17408, L_KT = 34816, L_VT = 53248, L_P = 71680, L_ST = 80896, L_TOT = 115712, L_ER = 119808, L_E2 = 120320;
constexpr int PQ = 136, PT = 72;

__device__ __forceinline__ int seq_nb(int s) { return s < 8 ? 4 : 32; }
__device__ __forceinline__ int seq_sb(int s) { return s < 8 ? 4 * s : 32 + 32 * (s - 8); }
__device__ __forceinline__ int slot_index(int s, int j, int head, int dir) { return ((seq_sb(s) + j) * 8 + head) * 2 + dir; }
__device__ __forceinline__ bf16x8 lds_frag(const unsigned char* lds, int byteoff) { return *(const bf16x8*)(lds + byteoff); }

struct ChunkRegs { unsigned k[8], v[8], q[8]; };
template <bool FULL>
__device__ __forceinline__ void chunk_prefetch(ChunkRegs& R, const u16* Qp, const u16* Kp, const u16* Vp, int row0, int col0, int tid) {
    const size_t g = (size_t)(row0 + 8 * (tid >> 6)) * D + col0 + 2 * (tid & 63);
#pragma unroll
    for (int i = 0; i < 8; ++i) { R.k[i] = *(const unsigned*)(Kp + g + (size_t)i * D); R.v[i] = *(const unsigned*)(Vp + g + (size_t)i * D); if (FULL) R.q[i] = *(const unsigned*)(Qp + g + (size_t)i * D); }
}
typedef float f32x2s __attribute__((ext_vector_type(2)));
#define LP(T, off) ((LAS T*)(lds + (off)))

template <bool FULL, bool BWD>
__device__ __forceinline__ void scan_chunk(LAS unsigned char* lds, ChunkRegs& R, const u16* nQp, const u16* nKp, const u16* nVp, int nrow0, bool has_next,
                                           u16* Of, u16* Oo, int row0, int nvalid, int col0, f32x4 (&S)[8], float (&dls)[2]) {
    constexpr bool bwd = BWD;
    const int tid = otid(), lane = tid & 63, w = tid >> 6, fr = lane & 15, fq = lane >> 4;
    const int cp = lane, tg = w;
    f32x2s G[8], kv[8], qv[8]; unsigned vw[8];
#pragma unroll
    for (int i = 0; i < 8; ++i) {
        const bool valid = (8 * tg + i) < nvalid;
        const unsigned kw = valid ? R.k[i] : 0u;
        kv[i] = (f32x2s){h2f((u16)(kw & 0xffffu)), h2f((u16)(kw >> 16))};
        const f32x2s fv = 1.0f - kv[i];
        G[i] = (f32x2s){fmaxf(fv.x, 1e-6f), fmaxf(fv.y, 1e-6f)};
        if (FULL) qv[i] = (f32x2s){__uint_as_float(R.q[i] << 16), __uint_as_float(R.q[i] & 0xffff0000u)};
        vw[i] = R.v[i];
    }
    f32x2s pr = {1.f, 1.f};
    if (!bwd) {
#pragma unroll
        for (int i = 0; i < 8; ++i) { pr = pr * G[i]; pr = (f32x2s){fmaxf(pr.x, 1e-30f), fmaxf(pr.y, 1e-30f)}; G[i] = pr; }
    } else {
#pragma unroll
        for (int i = 7; i >= 0; --i) { pr = pr * G[i]; pr = (f32x2s){fmaxf(pr.x, 1e-30f), fmaxf(pr.y, 1e-30f)}; G[i] = pr; }
    }
    *LP(f32x2s, L_TOT + (tg * 128 + 2 * cp) * 4) = (f32x2s){__logf(pr.x), __logf(pr.y)};
    if (has_next) chunk_prefetch<FULL>(R, nQp, nKp, nVp, nrow0, col0, tid);
    __syncthreads();
    {
        f32x2s t[8];
#pragma unroll
        for (int g = 0; g < 8; ++g) t[g] = *LP(f32x2s, L_TOT + (g * 128 + 2 * cp) * 4);
        const f32x2s lo4 = (t[0] + t[1]) + (t[2] + t[3]), hi4 = (t[4] + t[5]) + (t[6] + t[7]);
        const f32x2s BL = lo4 + hi4, r = bwd ? hi4 : lo4;
        f32x2s off = {0.f, 0.f};
#pragma unroll
        for (int g = 0; g < 8; ++g) { const bool take = bwd ? (g > tg) : (g < tg); if (take) off += t[g]; }
        const f32x2s cq = {__expf(fminf(off.x - r.x, 80.f)), __expf(fminf(off.y - r.y, 80.f))};
        const f32x2s ck = {__expf(fminf(r.x - off.x, 80.f)), __expf(fminf(r.y - off.y, 80.f))};
        unsigned khp[8];
#pragma unroll
        for (int i = 0; i < 8; ++i) {
            const int tl = 8 * tg + i;
            f32x2s m = ck * (f32x2s){__builtin_amdgcn_rcpf(G[i].x), __builtin_amdgcn_rcpf(G[i].y)};
            m = (f32x2s){fminf(m.x, 1e30f), fminf(m.y, 1e30f)};
            const f32x2s kh = kv[i] * m;
            khp[i] = pk_bf(kh.x, kh.y);
            if (FULL) {
                *LP(unsigned, L_KH + (tl * PQ + 2 * cp) * 2) = khp[i];
                const f32x2s qh = qv[i] * (cq * G[i]);
                *LP(unsigned, L_QH + (tl * PQ + 2 * cp) * 2) = pk_bf(qh.x, qh.y);
            }
        }
        u32x4 a, b;
        a.x = (khp[0] & 0xffffu) | (khp[1] << 16); a.y = (khp[2] & 0xffffu) | (khp[3] << 16); a.z = (khp[4] & 0xffffu) | (khp[5] << 16); a.w = (khp[6] & 0xffffu) | (khp[7] << 16);
        b.x = (khp[0] >> 16) | (khp[1] & 0xffff0000u); b.y = (khp[2] >> 16) | (khp[3] & 0xffff0000u); b.z = (khp[4] >> 16) | (khp[5] & 0xffff0000u); b.w = (khp[6] >> 16) | (khp[7] & 0xffff0000u);
        *LP(u32x4, L_KT + ((2 * cp) * PT + 8 * tg) * 2) = a; *LP(u32x4, L_KT + ((2 * cp + 1) * PT + 8 * tg) * 2) = b;
        a.x = (vw[0] & 0xffffu) | (vw[1] << 16); a.y = (vw[2] & 0xffffu) | (vw[3] << 16); a.z = (vw[4] & 0xffffu) | (vw[5] << 16); a.w = (vw[6] & 0xffffu) | (vw[7] << 16);
        b.x = (vw[0] >> 16) | (vw[1] & 0xffff0000u); b.y = (vw[2] >> 16) | (vw[3] & 0xffff0000u); b.z = (vw[4] >> 16) | (vw[5] & 0xffff0000u); b.w = (vw[6] >> 16) | (vw[7] & 0xffff0000u);
        *LP(u32x4, L_VT + ((2 * cp) * PT + 8 * tg) * 2) = a; *LP(u32x4, L_VT + ((2 * cp + 1) * PT + 8 * tg) * 2) = b;
        if (tg == 0) { *LP(f32x2s, L_ER + 2 * cp * 4) = (f32x2s){__expf(r.x), __expf(r.y)}; *LP(f32x2s, L_E2 + 2 * cp * 4) = (f32x2s){__expf(BL.x - r.x), __expf(BL.y - r.y)};
            dls[0] += BL.x; dls[1] += BL.y; }
    }
    __syncthreads();
    {
        const f32x4 er4 = *LP(f32x4, L_ER + (16 * w + 4 * fq) * 4);
#pragma unroll
        for (int i = 0; i < 8; ++i) {
            S[i] = S[i] * er4;
            if (FULL) { u32x2 pk; pk.x = pk_bf(S[i][0], S[i][1]); pk.y = pk_bf(S[i][2], S[i][3]); *LP(u32x2, L_ST + ((16 * i + fr) * PQ + 16 * w + 4 * fq) * 2) = pk; }
        }
    }
    const int tt = w & 3, hf = w >> 2;
    if (FULL) {
        bf16x8 qh[4], kf0[4], kf1[4];
#pragma unroll
        for (int kq = 0; kq < 4; ++kq) { qh[kq] = *LP(bf16x8, L_QH + ((16 * tt + fr) * PQ + 32 * kq + 8 * fq) * 2);
            kf0[kq] = *LP(bf16x8, L_KH + ((16 * (2 * hf) + fr) * PQ + 32 * kq + 8 * fq) * 2); kf1[kq] = *LP(bf16x8, L_KH + ((16 * (2 * hf + 1) + fr) * PQ + 32 * kq + 8 * fq) * 2); }
        __builtin_amdgcn_sched_barrier(0);
#pragma unroll
        for (int si = 0; si < 2; ++si) {
            const int st = 2 * hf + si;
            f32x4 acc = {0.f, 0.f, 0.f, 0.f};
#pragma unroll
            for (int kq = 0; kq < 4; ++kq)
                acc = __builtin_amdgcn_mfma_f32_16x16x32_bf16(si ? kf1[kq] : kf0[kq], qh[kq], acc, 0, 0, 0);
            const int tau = 16 * tt + fr, sg = 16 * st + 4 * fq;
            float pv[4];
#pragma unroll
            for (int j = 0; j < 4; ++j) { const bool keep = bwd ? (sg + j >= tau) : (sg + j <= tau); pv[j] = keep ? acc[j] : 0.f; }
            u32x2 pk; pk.x = pk_bf(pv[0], pv[1]); pk.y = pk_bf(pv[2], pv[3]);
            *LP(u32x2, L_P + (tau * PT + sg) * 2) = pk;
        }
        __syncthreads();
        f32x4 o[4];
        {
            bf16x8 pfr[2], sa[4], va2[2], sb[4], vb2[2];
#pragma unroll
            for (int sq = 0; sq < 2; ++sq) pfr[sq] = *LP(bf16x8, L_P + ((16 * tt + fr) * PT + 32 * sq + 8 * fq) * 2);
#pragma unroll
            for (int kq = 0; kq < 4; ++kq) sa[kq] = *LP(bf16x8, L_ST + ((16 * (4 * hf) + fr) * PQ + 32 * kq + 8 * fq) * 2);
#pragma unroll
            for (int sq = 0; sq < 2; ++sq) va2[sq] = *LP(bf16x8, L_VT + ((16 * (4 * hf) + fr) * PT + 32 * sq + 8 * fq) * 2);
#pragma unroll
            for (int i = 0; i < 4; i += 2) {
                const int vt1 = 4 * hf + i + 1;
#pragma unroll
                for (int kq = 0; kq < 4; ++kq) sb[kq] = *LP(bf16x8, L_ST + ((16 * vt1 + fr) * PQ + 32 * kq + 8 * fq) * 2);
#pragma unroll
                for (int sq = 0; sq < 2; ++sq) vb2[sq] = *LP(bf16x8, L_VT + ((16 * vt1 + fr) * PT + 32 * sq + 8 * fq) * 2);
                __builtin_amdgcn_sched_barrier(0);
                f32x4 acc = {0.f, 0.f, 0.f, 0.f};
#pragma unroll
                for (int kq = 0; kq < 4; ++kq) acc = __builtin_amdgcn_mfma_f32_16x16x32_bf16(sa[kq], qh[kq], acc, 0, 0, 0);
#pragma unroll
                for (int sq = 0; sq < 2; ++sq) acc = __builtin_amdgcn_mfma_f32_16x16x32_bf16(va2[sq], pfr[sq], acc, 0, 0, 0);
                o[i] = acc;
                if (i + 2 < 4) {
                    const int vt2 = 4 * hf + i + 2;
#pragma unroll
                    for (int kq = 0; kq < 4; ++kq) sa[kq] = *LP(bf16x8, L_ST + ((16 * vt2 + fr) * PQ + 32 * kq + 8 * fq) * 2);
#pragma unroll
                    for (int sq = 0; sq < 2; ++sq) va2[sq] = *LP(bf16x8, L_VT + ((16 * vt2 + fr) * PT + 32 * sq + 8 * fq) * 2);
                }
                __builtin_amdgcn_sched_barrier(0);
                f32x4 acc1 = {0.f, 0.f, 0.f, 0.f};
#pragma unroll
                for (int kq = 0; kq < 4; ++kq) acc1 = __builtin_amdgcn_mfma_f32_16x16x32_bf16(sb[kq], qh[kq], acc1, 0, 0, 0);
#pragma unroll
                for (int sq = 0; sq < 2; ++sq) acc1 = __builtin_amdgcn_mfma_f32_16x16x32_bf16(vb2[sq], pfr[sq], acc1, 0, 0, 0);
                o[i + 1] = acc1;
            }
        }
        const int tl = 16 * tt + fr;
        if (tl < nvalid) {
            const size_t ob = (size_t)(row0 + tl) * D + col0 + 64 * hf + 4 * fq;
            if (!bwd) {
#pragma unroll
                for (int i = 0; i < 4; ++i) { u32x2 pk; pk.x = pk_bf(o[i][0], o[i][1]); pk.y = pk_bf(o[i][2], o[i][3]); *(u32x2*)(Of + ob + 16 * i) = pk; }
            } else {
                u32x2 pf[4];
#pragma unroll
                for (int i = 0; i < 4; ++i) pf[i] = *(const u32x2*)(Of + ob + 16 * i);
#pragma unroll
                for (int i = 0; i < 4; ++i) {
                    const float a0 = o[i][0] + __uint_as_float(pf[i].x << 16), a1 = o[i][1] + __uint_as_float(pf[i].x & 0xffff0000u), a2 = o[i][2] + __uint_as_float(pf[i].y << 16), a3 = o[i][3] + __uint_as_float(pf[i].y & 0xffff0000u);
                    u32x2 pk; pk.x = pk_bf(a0, a1); pk.y = pk_bf(a2, a3); *(u32x2*)(Oo + ob + 16 * i) = pk; }
            }
        }
    }
    {
        bf16x8 ktf[2], vfa[4], vfb[4];
#pragma unroll
        for (int sq = 0; sq < 2; ++sq) { ktf[sq] = *LP(bf16x8, L_KT + ((16 * w + fr) * PT + 32 * sq + 8 * fq) * 2);
            vfa[sq] = *LP(bf16x8, L_VT + (fr * PT + 32 * sq + 8 * fq) * 2); vfa[2 + sq] = *LP(bf16x8, L_VT + ((16 + fr) * PT + 32 * sq + 8 * fq) * 2); }
#pragma unroll
        for (int i = 0; i < 8; i += 4) {
#pragma unroll
            for (int sq = 0; sq < 2; ++sq) { vfb[sq] = *LP(bf16x8, L_VT + ((16 * (i + 2) + fr) * PT + 32 * sq + 8 * fq) * 2); vfb[2 + sq] = *LP(bf16x8, L_VT + ((16 * (i + 3) + fr) * PT + 32 * sq + 8 * fq) * 2); }
            __builtin_amdgcn_sched_barrier(0);
#pragma unroll
            for (int sq = 0; sq < 2; ++sq) { S[i] = __builtin_amdgcn_mfma_f32_16x16x32_bf16(ktf[sq], vfa[sq], S[i], 0, 0, 0); S[i + 1] = __builtin_amdgcn_mfma_f32_16x16x32_bf16(ktf[sq], vfa[2 + sq], S[i + 1], 0, 0, 0); }
            if (i + 4 < 8) {
#pragma unroll
                for (int sq = 0; sq < 2; ++sq) { vfa[sq] = *LP(bf16x8, L_VT + ((16 * (i + 4) + fr) * PT + 32 * sq + 8 * fq) * 2); vfa[2 + sq] = *LP(bf16x8, L_VT + ((16 * (i + 5) + fr) * PT + 32 * sq + 8 * fq) * 2); }
            }
            __builtin_amdgcn_sched_barrier(0);
#pragma unroll
            for (int sq = 0; sq < 2; ++sq) { S[i + 2] = __builtin_amdgcn_mfma_f32_16x16x32_bf16(ktf[sq], vfb[sq], S[i + 2], 0, 0, 0); S[i + 3] = __builtin_amdgcn_mfma_f32_16x16x32_bf16(ktf[sq], vfb[2 + sq], S[i + 3], 0, 0, 0); }
        }
        const f32x4 e4 = *LP(f32x4, L_E2 + (16 * w + 4 * fq) * 4);
#pragma unroll
        for (int i = 0; i < 8; ++i) S[i] = S[i] * e4;
    }
}

__device__ __forceinline__ void block_chunks(int j, int nb, int& c_lo, int& c_hi) { c_lo = 8 * j; c_hi = (j == nb - 1) ? 8 * j + 9 : 8 * j + 8; }

__device__ __forceinline__ void state_load(const u16* slot, f32x4 (&S)[8], int w, int fr, int fq) {
#pragma unroll
    for (int i = 0; i < 8; ++i) { const u32x2 pk = *(const u32x2*)(slot + (16 * i + fr) * 128 + 16 * w + 4 * fq);
        S[i][0] = __uint_as_float(pk.x << 16); S[i][1] = __uint_as_float(pk.x & 0xffff0000u); S[i][2] = __uint_as_float(pk.y << 16); S[i][3] = __uint_as_float(pk.y & 0xffff0000u); }
}
__device__ __forceinline__ void state_zero(f32x4 (&S)[8]) {
#pragma unroll
    for (int i = 0; i < 8; ++i) S[i] = (f32x4){0.f, 0.f, 0.f, 0.f};
}

constexpr int LA_KT = 0, LA_VT = 34816, LA_TOT = 69632, LA_ER = 73728;
struct StepRegs { unsigned k[16], v[16]; };
__device__ __forceinline__ void step_prefetch(StepRegs& R, const u16* Kp, const u16* Vp, int row0, int col0, int tid) {
    const size_t g = (size_t)(row0 + 16 * (tid >> 6)) * D + col0 + 2 * (tid & 63);
#pragma unroll
    for (int i = 0; i < 16; ++i) { R.k[i] = *(const unsigned*)(Kp + g + (size_t)i * D); R.v[i] = *(const unsigned*)(Vp + g + (size_t)i * D); }
}
template <bool BWD>
__device__ __forceinline__ void scan_step_a(LAS unsigned char* lds, StepRegs& R, const u16* Kp, const u16* Vp, int nrow0, bool has_next, int nvalid, int col0, f32x4 (&S)[8], float (&dls)[2]) {
    const int tid = otid(), lane = tid & 63, w = tid >> 6, fr = lane & 15, fq = lane >> 4;
    const int cp = lane, tg = w;
    f32x2s kv[16], G[16]; unsigned vw[16];
#pragma unroll
    for (int i = 0; i < 16; ++i) {
        const bool valid = (16 * tg + i) < nvalid;
        const unsigned kw = valid ? R.k[i] : 0u;
        kv[i] = (f32x2s){h2f((u16)(kw & 0xffffu)), h2f((u16)(kw >> 16))};
        const f32x2s fv = 1.0f - kv[i];
        G[i] = (f32x2s){fmaxf(fv.x, 1e-6f), fmaxf(fv.y, 1e-6f)};
        vw[i] = valid ? R.v[i] : 0u;
    }
    f32x2s pr = {1.f, 1.f};
    if (!BWD) {
#pragma unroll
        for (int i = 15; i >= 0; --i) { const f32x2s fi = G[i]; G[i] = pr; pr = pr * fi; pr = (f32x2s){fmaxf(pr.x, 1e-30f), fmaxf(pr.y, 1e-30f)}; }
    } else {
#pragma unroll
        for (int i = 0; i < 16; ++i) { const f32x2s fi = G[i]; G[i] = pr; pr = pr * fi; pr = (f32x2s){fmaxf(pr.x, 1e-30f), fmaxf(pr.y, 1e-30f)}; }
    }
    *LP(f32x2s, LA_TOT + (tg * 128 + 2 * cp) * 4) = (f32x2s){__logf(pr.x), __logf(pr.y)};
    if (has_next) step_prefetch(R, Kp, Vp, nrow0, col0, tid);
    __syncthreads();
    {
        f32x2s t[8];
#pragma unroll
        for (int g = 0; g < 8; ++g) t[g] = *LP(f32x2s, LA_TOT + (g * 128 + 2 * cp) * 4);
        const f32x2s BL = ((t[0] + t[1]) + (t[2] + t[3])) + ((t[4] + t[5]) + (t[6] + t[7]));
        f32x2s off = {0.f, 0.f};
#pragma unroll
        for (int g = 0; g < 8; ++g) { const bool take = BWD ? (g < tg) : (g > tg); if (take) off += t[g]; }
        const f32x2s c = {__expf(off.x), __expf(off.y)};
        unsigned khp[16];
#pragma unroll
        for (int i = 0; i < 16; ++i) { const f32x2s kh = kv[i] * (c * G[i]); khp[i] = pk_bf(kh.x, kh.y); }
#pragma unroll
        for (int h = 0; h < 2; ++h) {
            u32x4 a, b;
            a.x = (khp[8 * h + 0] & 0xffffu) | (khp[8 * h + 1] << 16); a.y = (khp[8 * h + 2] & 0xffffu) | (khp[8 * h + 3] << 16); a.z = (khp[8 * h + 4] & 0xffffu) | (khp[8 * h + 5] << 16); a.w = (khp[8 * h + 6] & 0xffffu) | (khp[8 * h + 7] << 16);
            b.x = (khp[8 * h + 0] >> 16) | (khp[8 * h + 1] & 0xffff0000u); b.y = (khp[8 * h + 2] >> 16) | (khp[8 * h + 3] & 0xffff0000u); b.z = (khp[8 * h + 4] >> 16) | (khp[8 * h + 5] & 0xffff0000u); b.w = (khp[8 * h + 6] >> 16) | (khp[8 * h + 7] & 0xffff0000u);
            *LP(u32x4, LA_KT + ((2 * cp) * PQ + 16 * tg + 8 * h) * 2) = a; *LP(u32x4, LA_KT + ((2 * cp + 1) * PQ + 16 * tg + 8 * h) * 2) = b;
            a.x = (vw[8 * h + 0] & 0xffffu) | (vw[8 * h + 1] << 16); a.y = (vw[8 * h + 2] & 0xffffu) | (vw[8 * h + 3] << 16); a.z = (vw[8 * h + 4] & 0xffffu) | (vw[8 * h + 5] << 16); a.w = (vw[8 * h + 6] & 0xffffu) | (vw[8 * h + 7] << 16);
            b.x = (vw[8 * h + 0] >> 16) | (vw[8 * h + 1] & 0xffff0000u); b.y = (vw[8 * h + 2] >> 16) | (vw[8 * h + 3] & 0xffff0000u); b.z = (vw[8 * h + 4] >> 16) | (vw[8 * h + 5] & 0xffff0000u); b.w = (vw[8 * h + 6] >> 16) | (vw[8 * h + 7] & 0xffff0000u);
            *LP(u32x4, LA_VT + ((2 * cp) * PQ + 16 * tg + 8 * h) * 2) = a; *LP(u32x4, LA_VT + ((2 * cp + 1) * PQ + 16 * tg + 8 * h) * 2) = b;
        }
        if (tg == 0) { *LP(f32x2s, LA_ER + 2 * cp * 4) = (f32x2s){__expf(BL.x), __expf(BL.y)}; dls[0] += BL.x; dls[1] += BL.y; }
    }
    __syncthreads();
    const f32x4 er4 = *LP(f32x4, LA_ER + (16 * w + 4 * fq) * 4);
    bf16x8 kt[4], va[4], vb[4];
#pragma unroll
    for (int sq = 0; sq < 4; ++sq) { kt[sq] = *LP(bf16x8, LA_KT + ((16 * w + fr) * PQ + 32 * sq + 8 * fq) * 2); va[sq] = *LP(bf16x8, LA_VT + (fr * PQ + 32 * sq + 8 * fq) * 2); }
#pragma unroll
    for (int i = 0; i < 8; i += 2) {
#pragma unroll
        for (int sq = 0; sq < 4; ++sq) vb[sq] = *LP(bf16x8, LA_VT + ((16 * (i + 1) + fr) * PQ + 32 * sq + 8 * fq) * 2);
        __builtin_amdgcn_sched_barrier(0);
        S[i] = S[i] * er4;
#pragma unroll
        for (int sq = 0; sq < 4; ++sq) S[i] = __builtin_amdgcn_mfma_f32_16x16x32_bf16(kt[sq], va[sq], S[i], 0, 0, 0);
        if (i + 2 < 8) {
#pragma unroll
            for (int sq = 0; sq < 4; ++sq) va[sq] = *LP(bf16x8, LA_VT + ((16 * (i + 2) + fr) * PQ + 32 * sq + 8 * fq) * 2);
        }
        __builtin_amdgcn_sched_barrier(0);
        S[i + 1] = S[i + 1] * er4;
#pragma unroll
        for (int sq = 0; sq < 4; ++sq) S[i + 1] = __builtin_amdgcn_mfma_f32_16x16x32_bf16(kt[sq], vb[sq], S[i + 1], 0, 0, 0);
    }
}

__device__ void scan_pass_a(unsigned char* ldsg, const u16* KF, const u16* KB, const u16* V, u16* STs, float* DL) {
    LAS unsigned char* lds = (LAS unsigned char*)ldsg;
    const int tid = otid(), lane = tid & 63, w = tid >> 6, fr = lane & 15, fq = lane >> 4;
    for (int item = obid(); item < 1376; item += ogdim()) {
        const int hd = item / 86, rem = item - hd * 86, head = hd >> 1, dir = hd & 1;
        int s, jj; if (rem < 24) { s = rem / 3; jj = rem - 3 * s; } else { const int r2 = rem - 24; const int q = r2 / 31; s = 8 + q; jj = r2 - 31 * q; }
        const int nb = seq_nb(s), L = s < 8 ? LS : LL, j = dir ? jj + 1 : jj;
        int c_lo, c_hi; block_chunks(j, nb, c_lo, c_hi);
        f32x4 S[8]; state_zero(S); float dls[2] = {0.f, 0.f};
        const int base = seq_base(s), col0 = head * 128;
        const int tb = 64 * c_lo, te = (64 * c_hi < L) ? 64 * c_hi : L;
        const int ns = (te - tb + 127) >> 7;
        const u16* Kp = dir ? KB : KF;
        StepRegs R;
        step_prefetch(R, Kp, V, base + tb + 128 * (dir ? ns - 1 : 0), col0, tid);
        if (dir) {
            for (int si = ns - 1; si >= 0; --si) { const int t0 = tb + 128 * si; const int nvalid = (te - t0) < 128 ? (te - t0) : 128;
                scan_step_a<true>(lds, R, Kp, V, base + t0 - 128, si > 0, nvalid, col0, S, dls); }
        } else {
            for (int si = 0; si < ns; ++si) { const int t0 = tb + 128 * si; const int nvalid = (te - t0) < 128 ? (te - t0) : 128;
                scan_step_a<false>(lds, R, Kp, V, base + t0 + 128, si + 1 < ns, nvalid, col0, S, dls); }
        }
        const int sl = slot_index(s, j, head, dir);
        u16* slot = STs + (size_t)sl * 16384;
#pragma unroll
        for (int i = 0; i < 8; ++i) { u32x2 pk; pk.x = pk_bf(S[i][0], S[i][1]); pk.y = pk_bf(S[i][2], S[i][3]); *(u32x2*)(slot + (16 * i + fr) * 128 + 16 * w + 4 * fq) = pk; }
        if (tid < 64) *(f32x2s*)(DL + (size_t)sl * 128 + 2 * tid) = (f32x2s){dls[0], dls[1]};
        __syncthreads();
    }
}

__device__ void scan_pass_b(u16* STs, const float* DL) {
    const int tid = otid();
    for (int item = obid(); item < 1280; item += ogdim()) {
        const int slice = item & 7, shd = item >> 3, dir = shd & 1, head = (shd >> 1) & 7, s = shd >> 4;
        const int nb = seq_nb(s); const int e = slice * 2048 + tid * 4, k = e & 127;
        float S0 = 0.f, S1 = 0.f, S2 = 0.f, S3 = 0.f;
        for (int q0 = 0; q0 < nb - 1; q0 += 4) {
            u32x2 pk[4]; f32x4 dl[4]; u16* sp[4];
#pragma unroll
            for (int b = 0; b < 4; ++b) {
                const int q = (q0 + b < nb - 1) ? q0 + b : nb - 2; const int j = dir ? nb - 1 - q : q;
                const int sl = slot_index(s, j, head, dir);
                sp[b] = STs + (size_t)sl * 16384 + e; pk[b] = *(const u32x2*)sp[b]; dl[b] = *(const f32x4*)(DL + (size_t)sl * 128 + k);
            }
#pragma unroll
            for (int b = 0; b < 4; ++b) {
                if (q0 + b < nb - 1) {
                    S0 = __expf(dl[b][0]) * S0 + __uint_as_float(pk[b].x << 16); S1 = __expf(dl[b][1]) * S1 + __uint_as_float(pk[b].x & 0xffff0000u);
                    S2 = __expf(dl[b][2]) * S2 + __uint_as_float(pk[b].y << 16); S3 = __expf(dl[b][3]) * S3 + __uint_as_float(pk[b].y & 0xffff0000u);
                    u32x2 o; o.x = pk_bf(S0, S1); o.y = pk_bf(S2, S3); *(u32x2*)sp[b] = o;
                }
            }
        }
    }
}

__device__ void scan_pass_c(unsigned char* ldsg, u16* Q, u16* KF, const u16* KB, const u16* V, const u16* STs) {
    LAS unsigned char* lds = (LAS unsigned char*)ldsg;
    const int tid = otid(), lane = tid & 63, w = tid >> 6, fr = lane & 15, fq = lane >> 4;
    for (int item = obid(); item < 768; item += ogdim()) {
        const int head = item & 7, bj = item >> 3;
        int s, j; if (bj < 32) { s = bj >> 2; j = bj & 3; } else { s = 8 + ((bj - 32) >> 5); j = (bj - 32) & 31; }
        const int nb = seq_nb(s), L = s < 8 ? LS : LL, base = seq_base(s), col0 = head * 128;
        int c_lo, c_hi; block_chunks(j, nb, c_lo, c_hi);
        const int nc = c_hi - c_lo;
        f32x4 S[8]; float dls[2] = {0.f, 0.f};
        ChunkRegs R;
        chunk_prefetch<true>(R, Q, KF, V, base + 64 * c_lo, col0, tid);
        if (j == 0) state_zero(S); else state_load(STs + (size_t)slot_index(s, j - 1, head, 0) * 16384, S, w, fr, fq);
        for (int ci = 0; ci < nc; ++ci) {
            const int c = c_lo + ci; const int t0 = 64 * c; const int nvalid = (L - t0) < 64 ? (L - t0) : 64;
            const bool lastc = (ci + 1 == nc);
            scan_chunk<true, false>(lds, R, Q, lastc ? KB : (const u16*)KF, V, base + 64 * (lastc ? c : c + 1), true, KF, Q, base + t0, nvalid, col0, S, dls);
        }
        if (j == nb - 1) state_zero(S); else state_load(STs + (size_t)slot_index(s, j + 1, head, 1) * 16384, S, w, fr, fq);
        for (int ci = 0; ci < nc; ++ci) {
            const int c = c_hi - 1 - ci; const int t0 = 64 * c; const int nvalid = (L - t0) < 64 ? (L - t0) : 64;
            scan_chunk<true, true>(lds, R, Q, KB, V, base + 64 * (c - 1), ci + 1 < nc, KF, Q, base + t0, nvalid, col0, S, dls);
        }
    }
}

#define XB_TMO      128
#define XB_XCNT(j)  (256  + 64 * (j))
#define XB_XSUB(j)  (1280 + 64 * (j))
#define XB_XGEN(j)  (2304 + 64 * (j))
#define XB_TOP      3328
#define XB_TOPGEN   3392
#define XCD_BAR_WORDS 3456
#define XB_SPIN_CAP (1u << 18)
__device__ __forceinline__ unsigned xb_ld(unsigned* p)              { return __hip_atomic_load(p, __ATOMIC_RELAXED, __HIP_MEMORY_SCOPE_AGENT); }
__device__ __forceinline__ unsigned xb_add(unsigned* p, unsigned v) { return __hip_atomic_fetch_add(p, v, __ATOMIC_RELAXED, __HIP_MEMORY_SCOPE_AGENT); }
__device__ __forceinline__ unsigned xb_xcc_id() { return (unsigned)__builtin_amdgcn_s_getreg((3 << 11) | 20) & 0xFu; }
#define XB_SPIN(cond, bar) do { unsigned _sp = 0; while (cond) { __builtin_amdgcn_s_sleep(1); \
    if ((++_sp & 255u) == 0u) { if (xb_ld(&(bar)[XB_TMO])) break; if (_sp > XB_SPIN_CAP) { atomicAdd(&(bar)[XB_TMO], 1u); break; } } } } while (0)
struct XcdBarrier { unsigned* bar; unsigned x; volatile LAS unsigned* st; };
__device__ __forceinline__ XcdBarrier xcd_barrier_post(unsigned* bar, volatile LAS unsigned* st) {
    XcdBarrier b; b.bar = bar; b.x = xb_xcc_id(); b.st = st;
    if (threadIdx.x == 0) (void)xb_add(&bar[XB_XCNT(b.x)], 1u);
    return b;
}
__device__ __forceinline__ void xcd_barrier_complete(unsigned* bar, unsigned x, unsigned& nloc, unsigned& nx) {
    const unsigned G = gridDim.x * gridDim.y * gridDim.z;
    unsigned sum, cnt, mine, sp = 0u;
    for (;;) {
        sum = 0u; cnt = 0u; mine = 0u;
#pragma unroll
        for (unsigned j = 0; j < 16; ++j) { const unsigned c = xb_ld(&bar[XB_XCNT(j)]); sum += c; cnt += (c > 0u) ? 1u : 0u; mine = (j == x) ? c : mine; }
        if (sum == G) break;
        __builtin_amdgcn_s_sleep(1);
        if ((++sp & 255u) == 0u) { if (xb_ld(&bar[XB_TMO])) break; if (sp > XB_SPIN_CAP) { atomicAdd(&bar[XB_TMO], 1u); break; } }
    }
    nloc = mine > 0u ? mine : 1u; nx = cnt > 0u ? cnt : 1u;
}
__device__ __forceinline__ void xcd_barrier(const XcdBarrier& b) {
    asm volatile("s_waitcnt vmcnt(0)" ::: "memory");
    __syncthreads();
    if (threadIdx.x == 0) {
        unsigned* bar = b.bar;
        __builtin_amdgcn_s_waitcnt(0);
        unsigned nloc = b.st[0], nx = b.st[1];
        if (nloc == 0u) { xcd_barrier_complete(bar, b.x, nloc, nx); b.st[0] = nloc; b.st[1] = nx; }
        const unsigned old = xb_add(&bar[XB_XSUB(b.x)], 1u);
        const unsigned gen = old / nloc;
        if (old + 1u == (gen + 1u) * nloc) {
            __builtin_amdgcn_fence(__ATOMIC_RELEASE, "agent");
            asm volatile("s_waitcnt vmcnt(0)" ::: "memory");
            const unsigned og = xb_add(&bar[XB_TOP], 1u);
            const unsigned tg = og / nx;
            if (og + 1u == (tg + 1u) * nx) xb_add(&bar[XB_TOPGEN], 1u);
            else XB_SPIN(xb_ld(&bar[XB_TOPGEN]) == tg, bar);
            __builtin_amdgcn_fence(__ATOMIC_ACQUIRE, "agent");
            xb_add(&bar[XB_XGEN(b.x)], 1u);
            asm volatile("s_waitcnt vmcnt(0)" ::: "memory");
        } else {
            XB_SPIN(xb_ld(&bar[XB_XGEN(b.x)]) == gen, bar);
            __builtin_amdgcn_fence(__ATOMIC_ACQUIRE, "agent");
            asm volatile("s_waitcnt vmcnt(0)" ::: "memory");
        }
    }
    __syncthreads();
}

#ifndef MK_LAUNCHES
#define MK_LAUNCHES 1
#endif

__device__ __forceinline__ void mini_barrier(unsigned* word, unsigned nb) {
    asm volatile("s_waitcnt vmcnt(0)" ::: "memory");
    __syncthreads();
    if (threadIdx.x == 0) {
        __builtin_amdgcn_fence(__ATOMIC_RELEASE, "agent");
        asm volatile("s_waitcnt vmcnt(0)" ::: "memory");
        xb_add(word, 1u);
        unsigned sp = 0;
        while (xb_ld(word) < nb) { __builtin_amdgcn_s_sleep(1); if (++sp > (1u << 22)) break; }
        __builtin_amdgcn_fence(__ATOMIC_ACQUIRE, "agent");
        asm volatile("s_waitcnt vmcnt(0)" ::: "memory");
    }
    __syncthreads();
}
constexpr int N_PHASES = 19;
constexpr int ROWS_MAIN = 192 * 256;
__device__ __forceinline__ void run_phase(const int ph, const Params& p, unsigned char* lds) {
    int kind, l = 0, f = 0, sub = 0, gk = 0;
    if (ph == 0) kind = 0;
    else if (ph <= 2) { kind = ph == 1 ? 1 : 16; gk = 2; }
    else if (ph <= 5) { sub = 1; kind = ph == 3 ? 4 : (ph == 4 ? 5 : 16); gk = 6; }
    else if (ph <= 7) { sub = 2; f = 1; kind = ph == 6 ? 1 : 16; gk = 2; }
    else if (ph <= 9) { sub = 3; l = 1; kind = ph == 8 ? 1 : 16; gk = 2; }
    else if (ph <= 15) { sub = 4; l = 1; kind = ph <= 12 ? ph - 2 : (ph == 13 ? 11 : (ph == 14 ? 13 : 16)); gk = 14; }
    else { sub = 5; l = 1; f = 1; kind = ph - 15; }
    unsigned char* ws = p.ws;
    const bool last = (ph >= 16);
    const i64* sqcur = (const i64*)(ws + ((sub & 1) ? OFF_SQB : OFF_SQA));
    i64* sqnext = (i64*)(ws + ((sub & 1) ? OFF_SQA : OFF_SQB));
    const int bid = obid();
    const bool rowk = (kind == 3 || kind == 7 || kind == 15);
    const bool left1 = rowk && bid < 4;
    const bool left4 = (kind == 13) && bid < 4;
    if (kind == 0) { phase0(p, lds); return; }
    const int cpb = (bid & 7) * ((int)ogdim() >> 3) + (bid >> 3);
    const bool after_down = (ph == 3 || ph == 6 || ph == 8 || ph == 10 || ph == 16);
    const int hz = (ph == 6 || ph == 16) ? 1 : 0;
    const bool leftR = after_down && cpb < 4;
    const unsigned* ready = after_down ? (const unsigned*)(ws + OFF_DONE) : nullptr;
    if (kind == 1 || kind == 4 || kind == 8) {
        i64* sq1 = (i64*)(ws + OFF_SQ1); unsigned* cnt = (unsigned*)(ws + OFF_CNT);
        for (int i = bid * 512 + otid(); i < MPAD; i += (int)ogdim() * 512) { sq1[i] = 0; sqnext[i] = 0; if (i < 193) cnt[64 * i] = 0u; }
    }
    if (kind == 16 || leftR) {
        int el = l, ef = f, egk = gk;
        if (leftR) { egk = (ph == 6) ? 6 : (ph == 16 ? 14 : 2); el = (ph == 10 || ph == 16) ? 1 : 0; ef = (ph == 8) ? 1 : 0; }
        if (!leftR && bid == 0 && otid() < 256) { ((i64*)(ws + OFF_SQ1L))[otid()] = 0; if (otid() == 0) { *(unsigned*)(ws + OFF_CNTL) = 0u; *(unsigned*)(ws + OFF_DONE) = 0u; } }
        const size_t wbase = el ? OFF_W1 : OFF_W0;
        const size_t boff = (egk == 2) ? (ef ? WE_DN1 : WE_DN0) : (egk == 6 ? WE_SCOUT : WE_HGOUT);
        const int which = (egk == 2) ? (ef ? 2 : 0) : 1;
        EpiRes E{(u16*)(ws + OFF_HB), leftR ? (i64*)(ws + OFF_SQ1L) - ROWS_MAIN : (i64*)(ws + OFF_SQ1), leftR ? (i64*)sqcur : sqnext,
                 leftR ? (unsigned*)(ws + OFF_CNTL) - 64 * 192 : (unsigned*)(ws + OFF_CNT), p.in[4] + (el * 3 + which) * D, egk == 2 ? 0.5f : 1.0f, leftR ? (unsigned*)(ws + OFF_DONE) : nullptr};
        run_gemm_res(lds, (const u16*)(ws + OFF_ACT), (const u16*)(ws + wbase) + boff, egk == 2 ? DFF : D, E, leftR ? 4 : 5);
        if (!leftR) return;
    }
    if (kind == 1) {
        const u16* WL = (const u16*)(ws + (l ? OFF_W1 : OFF_W0));
        Epi<0> E{sqcur, (u16*)(ws + OFF_ACT), nullptr, nullptr, nullptr, nullptr, nullptr};
        run_gemm<0>(lds, (const u16*)(ws + OFF_HB), WL + (f ? WE_GU1 : WE_GU0), 2 * DFF, D, E, 0, ready, hz); return;
    }
    if (kind == 2 || kind == 6 || kind == 14 || left1) {
        const int gk = left1 ? kind - 1 : kind;
        const size_t wbase = l ? OFF_W1 : OFF_W0;
        const size_t boff = (gk == 2) ? (f ? WE_DN1 : WE_DN0) : (gk == 6 ? WE_SCOUT : WE_HGOUT);
        const int K = (gk == 2) ? DFF : D;
        const size_t foff = (gk == 2 && last) ? OFF_FF : 0;
        unsigned char* fbase = (gk == 2 && last) ? ws : (unsigned char*)p.out;
        Epi<1> E{nullptr, (u16*)(fbase + foff), nullptr, nullptr, nullptr, (float*)(ws + OFF_SSQ), nullptr};
        run_gemm<1>(lds, (const u16*)(ws + OFF_ACT), (const u16*)(ws + wbase) + boff, D, K, E, left1 ? 2 : 1);
        if (!left1) return;
        mini_barrier((unsigned*)(ws + OFF_BAR + 14336) + 64 * (ph & 7) + (ph >> 3) * 8, 4u);
    }
    if (rowk) {
        const int which = (kind == 3) ? (f ? 2 : 0) : 1;
        const u16* F = last ? (const u16*)(ws + OFF_FF) : (const u16*)p.out;
        row_update(F, (const float*)(ws + OFF_SSQ), p.in[4] + (l * 3 + which) * D, kind == 3 ? 0.5f : 1.0f, (u16*)(ws + OFF_HB), (float*)(ws + OFF_RS), last ? p.out : nullptr, p.in[15],
                   left1 ? ROWS_MAIN : 0, left1 ? MTOK : ROWS_MAIN, left1 ? bid : bid - 4, left1 ? 4 : (int)ogdim() - 4); return;
    }
    u16* B0 = (u16*)(ws + OFF_ACT); u16* B1 = (u16*)(ws + OFF_ACT + SZ_ROWS); u16* B2 = (u16*)(ws + OFF_FF);
    if (kind == 4) { Epi<2> E{sqcur, B0, B1, nullptr, nullptr, nullptr, nullptr}; run_gemm<2>(lds, (const u16*)(ws + OFF_HB), (const u16*)(ws + OFF_W0) + WE_MIXIN, 3072, D, E, 0, ready); return; }
    if (kind == 5) { conv_phase(B0, B1, p.in[9]); return; }
    if (kind == 8) { Epi<3> E{sqcur, B0, (u16*)p.out, B1, B2, nullptr, (const float*)(ws + OFF_LB)}; run_gemm<3>(lds, (const u16*)(ws + OFF_HB), (const u16*)(ws + OFF_W1) + WE_MIXIN, 4096, D, E, 0, ready); return; }
    if (kind == 9) { scan_pass_a(lds, B1, B2, (const u16*)p.out, (u16*)(ws + OFF_ST), (float*)(ws + OFF_DL)); return; }
    u16* G0 = (u16*)((unsigned char*)p.out + SZ_ROWS); u16* G1 = (u16*)(ws + OFF_ST + (size_t)1536 * 32768);
    if (kind == 10) scan_pass_b((u16*)(ws + OFF_ST), (const float*)(ws + OFF_DL));
    if (kind == 11) { scan_pass_c(lds, B0, B1, B2, (const u16*)p.out, (const u16*)(ws + OFF_ST)); return; }
    if (kind == 10 || left4) { Epi<4> E{sqcur, G0, G1, nullptr, nullptr, nullptr, nullptr}; run_gemm<4>(lds, (const u16*)(ws + OFF_HB), (const u16*)(ws + OFF_W1) + WE_MIXIN + (size_t)4096 * D, D, D, E, left4 ? 2 : 1);
        if (!left4) return;
        mini_barrier((unsigned*)(ws + OFF_BAR + 14336) + 64 * (ph & 7) + (ph >> 3) * 8, 4u); }
    if (kind == 13) { gate_norm_phase(B0, G0, G1, p.in[13], left4 ? ROWS_MAIN : 0, left4 ? MTOK : ROWS_MAIN, left4 ? bid : bid - 4, left4 ? 4 : (int)ogdim() - 4); return; }
}

__global__ void __launch_bounds__(512) fwd_megakernel(Params p) {
    extern __shared__ __attribute__((aligned(16))) unsigned char lds[];
    volatile LAS unsigned* stw = (volatile LAS unsigned*)((LAS unsigned char*)lds + 131072);
    if (threadIdx.x < 4) stw[threadIdx.x] = 0u;
    __syncthreads();
    XcdBarrier bar = xcd_barrier_post((unsigned*)(p.ws + OFF_BAR), stw);
#pragma unroll 1
    for (int ph = p.ph_lo; ph < p.ph_hi; ++ph) {
        run_phase(ph, p, lds);
        if (MK_LAUNCHES == 1 && ph + 1 < p.ph_hi) { if (ph == 0) cg::this_grid().sync(); else xcd_barrier(bar); }
    }
}

extern "C" void kernel_launch(void* const* d_in, const int* in_sizes, int n_in, void* d_out, int out_size, void* d_ws, size_t ws_size, hipStream_t stream) {
    static int grid = 0;
    if (grid == 0) {
        if (n_in != 16 || ws_size < WS_NEED) { fprintf(stderr, "kernel_launch: bad arguments (n_in %d, ws %zu < %zu)\n", n_in, ws_size, (size_t)WS_NEED); grid = -1; return; }
        int dev = 0, cus = 0, per_cu = 0;
        (void)hipGetDevice(&dev); (void)hipDeviceGetAttribute(&cus, hipDeviceAttributeMultiprocessorCount, dev);
        if (hipFuncSetAttribute((const void*)fwd_megakernel, hipFuncAttributeMaxDynamicSharedMemorySize, LDS_BYTES) != hipSuccess) { fprintf(stderr, "kernel_launch: hipFuncSetAttribute failed\n"); grid = -1; return; }
        if (hipOccupancyMaxActiveBlocksPerMultiprocessor(&per_cu, (const void*)fwd_megakernel, 512, LDS_BYTES) != hipSuccess || per_cu < 1) { fprintf(stderr, "kernel_launch: occupancy query gave %d\n", per_cu); per_cu = 1; }
        (void)hipGetLastError();
        grid = cus * 1;
    }
    if (grid < 0) return;
    Params p{};
    for (int i = 0; i < 16; ++i) p.in[i] = (const float*)d_in[i];
    p.out = (float*)d_out; p.ws = (unsigned char*)d_ws;
#if MK_LAUNCHES == 1
    if (hipMemsetAsync((char*)d_ws + OFF_BAR, 0, 16384, stream) != hipSuccess) { fprintf(stderr, "kernel_launch: memset failed\n"); return; }
    p.ph_lo = 0; p.ph_hi = N_PHASES;
    void* args[] = {&p};
    hipError_t e = hipLaunchCooperativeKernel((const void*)fwd_megakernel, dim3(grid), dim3(512), args, LDS_BYTES, stream);
    if (e != hipSuccess) fprintf(stderr, "cooperative launch failed: %s (grid %d)\n", hipGetErrorString(e), grid);
#else
    for (int k = 0; k < N_PHASES; ++k) { p.ph_lo = k; p.ph_hi = k + 1; hipLaunchKernelGGL(fwd_megakernel, dim3(grid), dim3(512), LDS_BYTES, stream, p); }
#endif
}
```

```cpp
#include <hip/hip_runtime.h>
#include <hip/hip_cooperative_groups.h>
#include <cstdio>
namespace cg = cooperative_groups;

__device__ __forceinline__ int otid() { int t = threadIdx.x; asm volatile("" : "+v"(t)); return t; }
__device__ __forceinline__ int obid() { int t = blockIdx.x; asm volatile("" : "+s"(t)); return t; }
__device__ __forceinline__ int ogdim() { int t = gridDim.x; asm volatile("" : "+s"(t)); return t; }
namespace pg8 {
#define PG8_LAS __attribute__((address_space(3)))
typedef unsigned short bf16_t;
typedef short bf16x8 __attribute__((ext_vector_type(8)));
typedef float f32x4 __attribute__((ext_vector_type(4)));
typedef unsigned u32x4 __attribute__((ext_vector_type(4)));
constexpr int BM = 256, BK = 64, HALF = 128, HTB = HALF * BK * 2  , STAGE_BYTES = 8 * HTB, NXCD = 8, WGM = 8;

__host__ __device__ __forceinline__ int lds_byte(int r, int c) { const int st = (r >> 4) * 2 + (c >> 5), rr = r & 15, cc = c & 31, ob = rr * 64 + cc * 2; return st * 1024 + (ob ^ (((ob >> 9) & 1) << 5)); }
__host__ __device__ __forceinline__ void stage_rc(int b, int& R, int& C) { const int st = b / 1024, sb = b % 1024, swz = sb ^ (((sb >> 9) & 1) << 5); R = (st >> 1) * 16 + swz / 64; C = (st & 1) * 32 + (swz % 64) / 2; }
__host__ __device__ __forceinline__ int perm32(int rho) { const int n = rho >> 4, i = rho & 15; return 8 * (i >> 2) + 4 * n + (i & 3); }

struct Unit { int pm, pn; };
struct Gemm { const bf16_t* A; const bf16_t* Bt; int M, N, K; };

struct StaticOrder {
    int nM, nN, nwg, G, c;
    __host__ __device__ void init(int M, int N, int G_, int c_) { nM = M / BM; nN = N / BM; nwg = nM * nN; G = G_; c = c_; }
    __host__ __device__ bool next(int i, Unit& u) const {
        const long L = (long)i * G + c; if (L >= nwg) return false;
        int wgid = (int)L; { const int q = nwg / NXCD, r = nwg % NXCD, xcd = wgid % NXCD, off = wgid / NXCD; wgid = (xcd < r ? xcd * (q + 1) : r * (q + 1) + (xcd - r) * q) + off; }
        const int nig = WGM * nN, gid = wgid / nig, fm = gid * WGM, gsz = (nM - fm) < WGM ? (nM - fm) : WGM;
        u.pm = fm + ((wgid % nig) % gsz); u.pn = (wgid % nig) / gsz; return true;
    }
    __device__ __forceinline__ void a_ready(const Unit&) const {}
    __device__ __forceinline__ void done(const Unit&) const {}
};
__device__ __forceinline__ unsigned cvt_pk_bf16(float lo, float hi) { unsigned r; asm volatile("v_cvt_pk_bf16_f32 %0, %1, %2" : "=v"(r) : "v"(lo), "v"(hi)); return r; }
template <class Epi, class Sched, bool ALIGN_EPI = false, bool SP2 = false>
__device__ __forceinline__ void gemm_phase(PG8_LAS unsigned char* lds, const Gemm g, const Sched& S, const Epi& E) {
    const int tid = otid(), wid = __builtin_amdgcn_readfirstlane(tid >> 6), lane = tid & 63, wr = wid >> 2, wc = wid & 3, fr = lane & 15, fq = lane >> 4;
    const int K = g.K, nt = K / BK;
    unsigned voffA[2], voffB[2];
#pragma unroll
    for (int i = 0; i < 2; ++i) { int R, C; stage_rc(tid * 16 + i * 8192, R, C); const int Rb = Epi::PERM ? ((R & ~31) + perm32(R & 31)) : R;
        voffA[i] = (unsigned)(R * K + C) * 2u; voffB[i] = (unsigned)(Rb * K + C) * 2u; }
    const size_t kstep = (size_t)(BK * 2);
    const size_t hstep = (size_t)HALF * K * 2;
    const size_t tstep = 2 * hstep;
    const unsigned ldsw = (unsigned)wid * 1024u;
    const int aoff = lds_byte(wr * 64 + fr, fq * 8), boff = lds_byte(wc * 32 + fr, fq * 8);
#define PG8_SA(b, h) (((b) * 2 + (h)) * HTB)
#define PG8_SB(b, h) ((4 + (b) * 2 + (h)) * HTB)
#define PG8_STAGE(bufoff, gbase, voff) do { _Pragma("unroll") for (int _i = 0; _i < 2; ++_i) \
        __builtin_amdgcn_global_load_lds((const unsigned*)((const char*)(gbase) + (voff)[_i]), (PG8_LAS unsigned*)(lds + (bufoff) + ldsw + _i * 8192), 16, 0, 0); } while (0)
#define PG8_LDA(dst, b, h) do { _Pragma("unroll") for (int m = 0; m < 4; ++m) _Pragma("unroll") for (int k = 0; k < 2; ++k) dst[m][k] = *(const PG8_LAS bf16x8*)(lds + PG8_SA(b, h) + aoff + m * 2048 + k * 1024); } while (0)
#define PG8_LDB(dst, b, h) do { _Pragma("unroll") for (int n = 0; n < 2; ++n) _Pragma("unroll") for (int k = 0; k < 2; ++k) dst[n][k] = *(const PG8_LAS bf16x8*)(lds + PG8_SB(b, h) + boff + n * 2048 + k * 1024); } while (0)
#define PG8_MMA(ai, bj, At, Bt) do { __builtin_amdgcn_s_setprio(1); _Pragma("unroll") for (int m = 0; m < 4; ++m) _Pragma("unroll") for (int n = 0; n < 2; ++n) _Pragma("unroll") for (int k = 0; k < 2; ++k) \
        acc[ai][bj][m][n] = __builtin_amdgcn_mfma_f32_16x16x32_bf16(Bt[n][k], At[m][k], acc[ai][bj][m][n], 0, 0, 0); __builtin_amdgcn_s_setprio(0); } while (0)
#define PG8_WAIT_V(n) asm volatile("s_waitcnt vmcnt(" #n ")" ::: "memory")
#define PG8_WAIT_L(n) asm volatile("s_waitcnt lgkmcnt(" #n ")" ::: "memory")
#define PG8_BAR __builtin_amdgcn_s_barrier()
#define PG8_SCHED __builtin_amdgcn_sched_barrier(0)
    Unit cur, nxt; int ui = 0;
    if (!S.next(0, cur)) return;
    f32x4 acc[2][2][4][2];
#pragma unroll
    for (int a = 0; a < 2; ++a)
#pragma unroll
        for (int b = 0; b < 2; ++b)
#pragma unroll
            for (int m = 0; m < 4; ++m)
#pragma unroll
                for (int n = 0; n < 2; ++n) acc[a][b][m][n] = (f32x4){0.f, 0.f, 0.f, 0.f};
    bf16x8 At[4][2], B0[2][2], B1[2][2];
    const char* cA = (const char*)g.A + (size_t)cur.pm * tstep; const char* cB = (const char*)g.Bt + (size_t)cur.pn * tstep;
    S.a_ready(cur);
    if constexpr (SP2) {
        PG8_STAGE(PG8_SB(0, 0), cB, voffB); PG8_STAGE(PG8_SB(0, 1), cB + hstep, voffB); PG8_STAGE(PG8_SA(0, 0), cA, voffA); PG8_STAGE(PG8_SA(0, 1), cA + hstep, voffA);
        if (wr == 1) PG8_BAR;
        PG8_WAIT_V(2); PG8_BAR;
        PG8_STAGE(PG8_SB(1, 0), cB + kstep, voffB); PG8_STAGE(PG8_SA(1, 0), cA + kstep, voffA); PG8_STAGE(PG8_SB(1, 1), cB + hstep + kstep, voffB);
        PG8_WAIT_V(6); PG8_BAR;
    } else {
        PG8_STAGE(PG8_SB(0, 0), cB, voffB); PG8_STAGE(PG8_SA(0, 0), cA, voffA); PG8_STAGE(PG8_SB(0, 1), cB + hstep, voffB); PG8_STAGE(PG8_SA(0, 1), cA + hstep, voffA);
        if (wr == 1) PG8_BAR;
        PG8_WAIT_V(4); PG8_BAR;
        PG8_STAGE(PG8_SB(1, 0), cB + kstep, voffB); PG8_STAGE(PG8_SA(1, 0), cA + kstep, voffA); PG8_STAGE(PG8_SB(1, 1), cB + hstep + kstep, voffB);
        PG8_WAIT_V(6); PG8_BAR;
    }
    for (;;) {
        const bool has_next = S.next(ui + 1, nxt);
        const char* nA = has_next ? (const char*)g.A + (size_t)nxt.pm * tstep : cA; const char* nB = has_next ? (const char*)g.Bt + (size_t)nxt.pn * tstep : cB;
        for (int t = 0; t < nt; t += 2) {
            const bool last = (t == nt - 2);
            const char* a1 = cA + (size_t)(t + 1) * kstep;
            const char* a2 = last ? nA : cA + (size_t)(t + 2) * kstep; const char* b2 = last ? nB : cB + (size_t)(t + 2) * kstep;
            const char* a3 = a2 + kstep; const char* b3 = b2 + kstep;
            if (last && has_next) S.a_ready(nxt);
            if constexpr (SP2) {
            PG8_LDB(B0, 0, 0); PG8_LDB(B1, 0, 1); PG8_SCHED; PG8_LDA(At, 0, 0); PG8_STAGE(PG8_SA(1, 1), a1 + hstep, voffA);
            PG8_WAIT_V(8); PG8_WAIT_L(0); PG8_BAR; PG8_MMA(0, 0, At, B0); PG8_MMA(0, 1, At, B1); PG8_BAR; PG8_SCHED;
            PG8_LDA(At, 0, 1); PG8_STAGE(PG8_SB(0, 0), b2, voffB); PG8_STAGE(PG8_SB(0, 1), b2 + hstep, voffB); PG8_STAGE(PG8_SA(0, 0), a2, voffA);
            PG8_WAIT_V(8); PG8_WAIT_L(0); PG8_BAR; PG8_MMA(1, 0, At, B0); PG8_MMA(1, 1, At, B1); PG8_BAR; PG8_SCHED;
            PG8_LDB(B0, 1, 0); PG8_LDB(B1, 1, 1); PG8_SCHED; PG8_LDA(At, 1, 0); PG8_STAGE(PG8_SA(0, 1), a2 + hstep, voffA);
            PG8_WAIT_V(8); PG8_WAIT_L(0); PG8_BAR; PG8_MMA(0, 0, At, B0); PG8_MMA(0, 1, At, B1); PG8_BAR; PG8_SCHED;
            PG8_LDA(At, 1, 1); PG8_STAGE(PG8_SB(1, 0), b3, voffB); PG8_STAGE(PG8_SB(1, 1), b3 + hstep, voffB); PG8_STAGE(PG8_SA(1, 0), a3, voffA);
            PG8_WAIT_V(8); PG8_WAIT_L(0); PG8_BAR; PG8_MMA(1, 0, At, B0); PG8_MMA(1, 1, At, B1); PG8_BAR; PG8_SCHED;
            } else {
            PG8_LDB(B0, 0, 0); PG8_SCHED; PG8_LDA(At, 0, 0); PG8_STAGE(PG8_SA(1, 1), a1 + hstep, voffA);
            PG8_WAIT_L(8); PG8_BAR; PG8_WAIT_L(0); PG8_MMA(0, 0, At, B0); PG8_BAR; PG8_SCHED;
            PG8_LDB(B1, 0, 1); PG8_STAGE(PG8_SB(0, 0), b2, voffB);
            PG8_BAR; PG8_WAIT_L(0); PG8_MMA(0, 1, At, B1); PG8_BAR;
            PG8_LDA(At, 0, 1); PG8_STAGE(PG8_SA(0, 0), a2, voffA);
            PG8_BAR; PG8_WAIT_L(0); PG8_MMA(1, 0, At, B0); PG8_BAR; PG8_SCHED;
            PG8_STAGE(PG8_SB(0, 1), b2 + hstep, voffB);
            PG8_WAIT_V(6); PG8_BAR; PG8_MMA(1, 1, At, B1); PG8_BAR;
            PG8_LDB(B0, 1, 0); PG8_SCHED; PG8_LDA(At, 1, 0); PG8_STAGE(PG8_SA(0, 1), a2 + hstep, voffA);
            PG8_WAIT_L(8); PG8_BAR; PG8_WAIT_L(0); PG8_MMA(0, 0, At, B0); PG8_BAR; PG8_SCHED;
            PG8_LDB(B1, 1, 1); PG8_STAGE(PG8_SB(1, 0), b3, voffB);
            PG8_BAR; PG8_WAIT_L(0); PG8_MMA(0, 1, At, B1); PG8_BAR;
            PG8_LDA(At, 1, 1); PG8_STAGE(PG8_SA(1, 0), a3, voffA);
            PG8_BAR; PG8_WAIT_L(0); PG8_MMA(1, 0, At, B0); PG8_BAR; PG8_SCHED;
            PG8_STAGE(PG8_SB(1, 1), b3 + hstep, voffB);
            PG8_WAIT_V(6); PG8_BAR; PG8_MMA(1, 1, At, B1); PG8_BAR;
            }
        }
        if constexpr (ALIGN_EPI) { if (wr == 0) PG8_BAR; }
        if constexpr (!Epi::AFTER_DRAIN) { E(acc, cur, wr, wc, fr, fq); S.done(cur); }
        if (!has_next) break;
#pragma unroll
        for (int a = 0; a < 2; ++a)
#pragma unroll
            for (int b = 0; b < 2; ++b)
#pragma unroll
                for (int m = 0; m < 4; ++m)
#pragma unroll
                    for (int n = 0; n < 2; ++n) acc[a][b][m][n] = (f32x4){0.f, 0.f, 0.f, 0.f};
        cur = nxt; cA = nA; cB = nB; ++ui;
        if constexpr (ALIGN_EPI) { if (wr == 1) PG8_BAR; }
    }
    PG8_WAIT_V(0);
    if constexpr (!ALIGN_EPI) { if (wr == 0) PG8_BAR; }
    PG8_BAR;
    if constexpr (Epi::AFTER_DRAIN) { E.fused(acc, cur, wr, wc, fr, fq, lds, wid, lane); S.done(cur); }
#undef PG8_SA
#undef PG8_SB
#undef PG8_STAGE
#undef PG8_LDA
#undef PG8_LDB
#undef PG8_MMA
#undef PG8_WAIT_V
#undef PG8_WAIT_L
#undef PG8_BAR
#undef PG8_SCHED
}
}

typedef unsigned short u16;
typedef long long i64;
constexpr float FIXS = 1048576.0f, FIXI = 1.0f / 1048576.0f;
typedef _Float16 f16;
typedef _Float16 f16x2 __attribute__((ext_vector_type(2)));
using pg8::bf16x8; using pg8::f32x4; using pg8::u32x4;
typedef unsigned u32x2 __attribute__((ext_vector_type(2)));
#define LAS __attribute__((address_space(3)))

constexpr int D = 1024, DFF = 2816;
constexpr int LS = 2064, LL = 16400, SS = 2048, SL = 16384;
constexpr int MTOK = 8 * LS + 2 * LL;
constexpr int MPAD = 49408;
constexpr int NPROW = 8 * LS;
constexpr float EPS = 1e-6f;
constexpr int G_SPLIT = 48896;
constexpr int LDS_BYTES = 131072 + 16;

constexpr size_t SZ_ROWS = (size_t)MPAD * D * 2;
constexpr size_t OFF_W1 = 0;
constexpr size_t OFF_HB = 47185920;
constexpr size_t OFF_RS = OFF_HB + SZ_ROWS;
constexpr size_t OFF_SSQ = OFF_RS + (size_t)MPAD * 4;
constexpr size_t OFF_ACT = OFF_SSQ + (size_t)16 * MPAD * 4;
constexpr size_t OFF_FF = OFF_ACT + (size_t)MPAD * DFF * 2;
constexpr size_t OFF_END = OFF_FF + SZ_ROWS;
constexpr size_t OFF_W0 = OFF_END - 42991616;
constexpr size_t OFF_LB = OFF_END;
constexpr size_t OFF_DL = OFF_END + 8192;
constexpr size_t OFF_ST = OFF_ACT + 2 * SZ_ROWS;
constexpr size_t OFF_BAR = OFF_DL + (size_t)1536 * 128 * 4;
constexpr size_t OFF_SQ1 = OFF_BAR + 16384;
constexpr size_t OFF_SQA = OFF_SQ1 + (size_t)MPAD * 8;
constexpr size_t OFF_SQB = OFF_SQA + (size_t)MPAD * 8;
constexpr size_t OFF_CNT = OFF_SQB + (size_t)MPAD * 8;
constexpr size_t OFF_SQ1L = OFF_CNT + (size_t)193 * 256;
constexpr size_t OFF_CNTL = OFF_SQ1L + 2048;
constexpr size_t OFF_DONE = OFF_CNTL + 256;
constexpr size_t WS_NEED = OFF_DONE + 256;
constexpr size_t WE_GU0 = 0, WE_DN0 = 5767168, WE_GU1 = 8650752, WE_DN1 = 14417920, WE_MIXIN = 17301504;
constexpr size_t WE_SCOUT = WE_MIXIN + 3145728, WE_HGOUT = WE_MIXIN + 5242880;

struct Params { const float* in[16]; float* out; unsigned char* ws; int ph_lo, ph_hi; };

__device__ __forceinline__ float bf2f(u16 b) { return __uint_as_float(((unsigned)b) << 16); }
__device__ __forceinline__ u16 f2bf(float f) { unsigned u = __float_as_uint(f); u += 0x7FFFu + ((u >> 16) & 1u); return (u16)(u >> 16); }
__device__ __forceinline__ unsigned pk_bf(float a, float b) { return pg8::cvt_pk_bf16(a, b); }
__device__ __forceinline__ unsigned pk_h(float a, float b) { f16x2 h = {(f16)a, (f16)b}; return __builtin_bit_cast(unsigned, h); }
__device__ __forceinline__ float h2f(u16 b) { return (float)__builtin_bit_cast(f16, b); }
__device__ __forceinline__ float silu_f(float x) { return x * __builtin_amdgcn_rcpf(1.0f + __expf(-x)); }
__device__ __forceinline__ float wave_sum(float v) {
#pragma unroll
    for (int o = 1; o < 64; o <<= 1) v += __shfl_xor(v, o);
    return v;
}
__device__ __forceinline__ void row_decode(int row, int& s, int& t, int& L) {
    if (row < NPROW) { s = row / LS; t = row - s * LS; L = LS; }
    else { const int r2 = row - NPROW; const int q = r2 / LL; s = 8 + q; t = r2 - q * LL; L = LL; }
}
__device__ __forceinline__ int seq_base(int s) { return s < 8 ? s * LS : NPROW + (s - 8) * LL; }

__device__ __forceinline__ void unpack8(const u32x4 w, float (&o)[8]) {
    o[0] = __uint_as_float(w.x << 16); o[1] = __uint_as_float(w.x & 0xffff0000u); o[2] = __uint_as_float(w.y << 16); o[3] = __uint_as_float(w.y & 0xffff0000u);
    o[4] = __uint_as_float(w.z << 16); o[5] = __uint_as_float(w.z & 0xffff0000u); o[6] = __uint_as_float(w.w << 16); o[7] = __uint_as_float(w.w & 0xffff0000u);
}
__device__ __forceinline__ u32x4 pack8(const float (&o)[8]) { u32x4 w; w.x = pk_bf(o[0], o[1]); w.y = pk_bf(o[2], o[3]); w.z = pk_bf(o[4], o[5]); w.w = pk_bf(o[6], o[7]); return w; }


template <int MODE> struct Epi {
    static constexpr bool PERM = true, AFTER_DRAIN = false;
    const i64* rs; u16* o0; u16* o1; u16* o2; u16* o3; float* ssq; const float* lb;
    __device__ __forceinline__ void operator()(const f32x4 (&acc)[2][2][4][2], const pg8::Unit& u, int wr, int wc, int fr, int fq) const {
        const int row0 = u.pm * 256 + wr * 64 + fr;
        const int cw = wc * 32 + 8 * fq;
        float sc[2][4];
        if (MODE != 1) {
            i64 raw[2][4];
#pragma unroll
            for (int ai = 0; ai < 2; ++ai)
#pragma unroll
                for (int m = 0; m < 4; ++m) raw[ai][m] = rs[row0 + ai * 128 + m * 16];
#pragma unroll
            for (int ai = 0; ai < 2; ++ai)
#pragma unroll
                for (int m = 0; m < 4; ++m) sc[ai][m] = rsqrtf((float)raw[ai][m] * (FIXI / D) + EPS);
        }
        float oml[2][8];
        if (MODE == 3) {
            const int part3 = u.pn >> 2;
#pragma unroll
            for (int bj = 0; bj < 2; ++bj) {
                f32x4 l0 = {0.f, 0.f, 0.f, 0.f}, l1 = {0.f, 0.f, 0.f, 0.f};
                if (part3 >= 2) { const float* lbp = lb + (part3 - 2) * D + (u.pn & 3) * 256 + bj * 128 + cw; l0 = *(const f32x4*)lbp; l1 = *(const f32x4*)(lbp + 4); }
                oml[bj][0] = 1.0f - l0[0]; oml[bj][1] = 1.0f - l0[1]; oml[bj][2] = 1.0f - l0[2]; oml[bj][3] = 1.0f - l0[3];
                oml[bj][4] = 1.0f - l1[0]; oml[bj][5] = 1.0f - l1[1]; oml[bj][6] = 1.0f - l1[2]; oml[bj][7] = 1.0f - l1[3];
            }
        }
#pragma unroll
        for (int ai = 0; ai < 2; ++ai)
#pragma unroll
            for (int m = 0; m < 4; ++m) {
                const int row = row0 + ai * 128 + m * 16;
                if (MODE == 0) {
                    typedef float f2 __attribute__((ext_vector_type(2)));
                    const float s = sc[ai][m]; const float c1 = -1.44269504f * s, s2 = s * s;
                    unsigned wv[4];
#pragma unroll
                    for (int n = 0; n < 2; ++n)
#pragma unroll
                        for (int jp = 0; jp < 2; ++jp) {
                            const f2 ag = {acc[ai][0][m][n][2 * jp], acc[ai][0][m][n][2 * jp + 1]}, au = {acc[ai][1][m][n][2 * jp], acc[ai][1][m][n][2 * jp + 1]};
                            const f2 t = ag * c1; f2 e; e.x = __builtin_amdgcn_exp2f(t.x); e.y = __builtin_amdgcn_exp2f(t.y);
                            const f2 d = e + 1.0f; f2 r; r.x = __builtin_amdgcn_rcpf(d.x); r.y = __builtin_amdgcn_rcpf(d.y);
                            const f2 o = (ag * au) * (r * s2);
                            wv[n * 2 + jp] = pk_bf(o.x, o.y);
                        }
                    u32x4 w; w.x = wv[0]; w.y = wv[1]; w.z = wv[2]; w.w = wv[3];
                    *(u32x4*)(o0 + (size_t)row * DFF + u.pn * 128 + cw) = w;
                } else if (MODE == 1) {
                    float ss = 0.f;
#pragma unroll
                    for (int bj = 0; bj < 2; ++bj) {
                        const f32x4 v0 = acc[ai][bj][m][0], v1 = acc[ai][bj][m][1];
                        ss += v0[0] * v0[0] + v0[1] * v0[1] + v0[2] * v0[2] + v0[3] * v0[3] + v1[0] * v1[0] + v1[1] * v1[1] + v1[2] * v1[2] + v1[3] * v1[3];
                        u32x4 w; w.x = pk_bf(v0[0], v0[1]); w.y = pk_bf(v0[2], v0[3]); w.z = pk_bf(v1[0], v1[1]); w.w = pk_bf(v1[2], v1[3]);
                        *(u32x4*)(o0 + (size_t)row * D + u.pn * 256 + bj * 128 + cw) = w;
                    }
                    ss += __shfl_xor(ss, 16); ss += __shfl_xor(ss, 32);
                    if (fq == 0) ssq[(size_t)(u.pn * 4 + wc) * MPAD + row] = ss;
                } else if (MODE == 2) {
                    const float s = sc[ai][m];
                    if (u.pn < 4) {
#pragma unroll
                        for (int bj = 0; bj < 2; ++bj) {
                            const f32x4 v0 = acc[ai][bj][m][0] * s, v1 = acc[ai][bj][m][1] * s;
                            u32x4 w; w.x = pk_bf(v0[0], v0[1]); w.y = pk_bf(v0[2], v0[3]); w.z = pk_bf(v1[0], v1[1]); w.w = pk_bf(v1[2], v1[3]);
                            *(u32x4*)(o0 + (size_t)row * D + u.pn * 256 + bj * 128 + cw) = w;
                        }
                    } else {
                        const float s2 = s * s;
                        const f32x4 v0 = acc[ai][0][m][0] * acc[ai][1][m][0] * s2, v1 = acc[ai][0][m][1] * acc[ai][1][m][1] * s2;
                        u32x4 w; w.x = pk_bf(v0[0], v0[1]); w.y = pk_bf(v0[2], v0[3]); w.z = pk_bf(v1[0], v1[1]); w.w = pk_bf(v1[2], v1[3]);
                        *(u32x4*)(o1 + (size_t)row * D + (u.pn - 4) * 128 + cw) = w;
                    }
                } else if (MODE == 3) {
                    const float s = sc[ai][m];
                    const int part = u.pn >> 2;
#pragma unroll
                    for (int bj = 0; bj < 2; ++bj) {
                        const int c = (u.pn & 3) * 256 + bj * 128 + cw;
                        const f32x4 v0 = acc[ai][bj][m][0] * s, v1 = acc[ai][bj][m][1] * s;
                        float x[8] = {v0[0], v0[1], v0[2], v0[3], v1[0], v1[1], v1[2], v1[3]};
                        u32x4 w;
                        if (part == 0) {
#pragma unroll
                            for (int e = 0; e < 8; ++e) x[e] = silu_f(x[e]);
                            w.x = pk_bf(x[0], x[1]); w.y = pk_bf(x[2], x[3]); w.z = pk_bf(x[4], x[5]); w.w = pk_bf(x[6], x[7]);
                            *(u32x4*)(o0 + (size_t)row * D + c) = w;
                        } else if (part == 1) {
                            w.x = pk_bf(x[0], x[1]); w.y = pk_bf(x[2], x[3]); w.z = pk_bf(x[4], x[5]); w.w = pk_bf(x[6], x[7]);
                            *(u32x4*)(o1 + (size_t)row * D + c) = w;
                        } else {
#pragma unroll
                            for (int e = 0; e < 8; ++e) x[e] = oml[bj][e] * __builtin_amdgcn_rcpf(1.0f + __expf(x[e]));
                            w.x = pk_h(x[0], x[1]); w.y = pk_h(x[2], x[3]); w.z = pk_h(x[4], x[5]); w.w = pk_h(x[6], x[7]);
                            *(u32x4*)((part == 2 ? o2 : o3) + (size_t)row * D + c) = w;
                        }
                    }
                } else {
                    const float s = sc[ai][m];
#pragma unroll
                    for (int bj = 0; bj < 2; ++bj) {
                        const f32x4 v0 = acc[ai][bj][m][0] * s, v1 = acc[ai][bj][m][1] * s;
                        u32x4 w; w.x = pk_bf(silu_f(v0[0]), silu_f(v0[1])); w.y = pk_bf(silu_f(v0[2]), silu_f(v0[3])); w.z = pk_bf(silu_f(v1[0]), silu_f(v1[1])); w.w = pk_bf(silu_f(v1[2]), silu_f(v1[3]));
                        u16* gd = row < G_SPLIT ? o0 + (size_t)row * D : o1 + (size_t)(row - G_SPLIT) * D;
                        *(u32x4*)(gd + u.pn * 256 + bj * 128 + cw) = w;
                    }
                }
            }
    }
};

struct SplitOrder : pg8::StaticOrder {
    int part; int hz; const unsigned* ready;
    __device__ __forceinline__ bool next(int i, pg8::Unit& u) const {
        if (part == 2) { if (i == 0 && c < nN) { u.pm = 192; u.pn = c; return true; } return false; }
        if (part >= 3) {
            const int cp = (c & 7) * (G >> 3) + (c >> 3);
            if (part == 4) { if (i == 0 && cp < 4) { u.pm = 192; u.pn = cp; return true; } return false; }
            const long Lp = (long)i * G + cp; u.pm = (int)(Lp >> 2); u.pn = (int)(Lp & 3); return u.pm < (part == 5 ? 192 : 193); }
        if (part == 0 && ready != nullptr) {
            const int nfull = nwg / G, rem = nwg - nfull * G;
            const int cp = (c & 7) * (G >> 3) + (c >> 3);
            if (cp < 4) { const int mine = nfull + (c < rem ? 1 : 0); if (i >= mine - 3) return false; }
            else { const int k = G - 1 - c;
                if (k < 12 && c >= rem && i == nfull) {
                    const int q = k / 3, cl = q * 8;
                    const int cnt_l = nfull + (cl < rem ? 1 : 0);
                    SplitOrder t = *this; t.c = cl;
                    return t.pg8::StaticOrder::next(cnt_l - 3 + (k - 3 * q), u);
                } }
        }
        return pg8::StaticOrder::next(i, u);
    }
    __device__ __forceinline__ void a_ready(const pg8::Unit& u) const {
        if (ready != nullptr && (u.pm == 192 || (hz && (u.pm == 69 || u.pm == 70)))) {
            if (threadIdx.x < 64) {
                unsigned sp = 0;
                while ((unsigned)__builtin_amdgcn_readfirstlane(__hip_atomic_load(ready, __ATOMIC_RELAXED, __HIP_MEMORY_SCOPE_AGENT)) < 32u) { __builtin_amdgcn_s_sleep(2); if (++sp > (1u << 19)) break; }
                __builtin_amdgcn_fence(__ATOMIC_ACQUIRE, "agent");
                asm volatile("s_waitcnt vmcnt(0)" ::: "memory");
            }
            asm volatile("" ::: "memory"); __builtin_amdgcn_s_barrier(); asm volatile("" ::: "memory");
        }
    }
};
template <int MODE>
__device__ __forceinline__ void run_gemm(unsigned char* lds, const u16* A, const u16* Bt, int N, int K, const Epi<MODE>& E, int part, const unsigned* ready = nullptr, int hz = 0) {
    pg8::Gemm g{A, Bt, MPAD, N, K}; SplitOrder S; S.init(part == 0 ? MPAD : 192 * 256, N, (int)ogdim(), (int)obid()); S.part = part; S.ready = ready; S.hz = hz;
    pg8::gemm_phase<Epi<MODE>, SplitOrder, true, true>((LAS unsigned char*)lds, g, S, E);
}


struct EpiRes {
    static constexpr bool PERM = true, AFTER_DRAIN = false;
    u16* HB; i64* ssq1; i64* ssq2; unsigned* cnt; const float* gpost; float coef; unsigned* done;
    __device__ __forceinline__ void operator()(const f32x4 (&acc)[2][2][4][2], const pg8::Unit& u, int wr, int wc, int fr, int fq) const {
        const int row0 = u.pm * 256 + wr * 64 + fr;
        const int colb = u.pn * 256 + wc * 32 + 8 * fq;
#pragma unroll
        for (int ai = 0; ai < 2; ++ai)
#pragma unroll
            for (int m = 0; m < 4; ++m) {
                float ss = 0.f;
#pragma unroll
                for (int bj = 0; bj < 2; ++bj) { const f32x4 v0 = acc[ai][bj][m][0], v1 = acc[ai][bj][m][1];
                    ss += v0[0] * v0[0] + v0[1] * v0[1] + v0[2] * v0[2] + v0[3] * v0[3] + v1[0] * v1[0] + v1[1] * v1[1] + v1[2] * v1[2] + v1[3] * v1[3]; }
                ss += __shfl_xor(ss, 16); ss += __shfl_xor(ss, 32);
                if (fq == 0) (void)__hip_atomic_fetch_add(ssq1 + row0 + ai * 128 + m * 16, (i64)(ss * FIXS + 0.5f), __ATOMIC_RELAXED, __HIP_MEMORY_SCOPE_AGENT);
            }
        asm volatile("s_waitcnt vmcnt(0)" ::: "memory");
        unsigned* pc = cnt + 64 * u.pm;
        if (fr == 0 && fq == 0) (void)__hip_atomic_fetch_add(pc, 1u, __ATOMIC_RELAXED, __HIP_MEMORY_SCOPE_AGENT);
        u32x4 hraw[4][2];
#pragma unroll
        for (int m = 0; m < 4; ++m)
#pragma unroll
            for (int bj = 0; bj < 2; ++bj) hraw[m][bj] = *(const u32x4*)(HB + (size_t)(row0 + m * 16) * D + colb + bj * 128);
        float g[2][8];
#pragma unroll
        for (int bj = 0; bj < 2; ++bj) { const f32x4 a = *(const f32x4*)(gpost + colb + bj * 128), b = *(const f32x4*)(gpost + colb + bj * 128 + 4);
            g[bj][0] = a[0] * coef; g[bj][1] = a[1] * coef; g[bj][2] = a[2] * coef; g[bj][3] = a[3] * coef; g[bj][4] = b[0] * coef; g[bj][5] = b[1] * coef; g[bj][6] = b[2] * coef; g[bj][7] = b[3] * coef; }
        { unsigned sp = 0;
          while ((unsigned)__builtin_amdgcn_readfirstlane(__hip_atomic_load(pc, __ATOMIC_RELAXED, __HIP_MEMORY_SCOPE_AGENT)) < 32u) { __builtin_amdgcn_s_sleep(2); if (++sp > (1u << 19)) break; } }
        float tot[2][4];
#pragma unroll
        for (int ai = 0; ai < 2; ++ai)
#pragma unroll
            for (int m = 0; m < 4; ++m) tot[ai][m] = (float)__hip_atomic_load(ssq1 + row0 + ai * 128 + m * 16, __ATOMIC_RELAXED, __HIP_MEMORY_SCOPE_AGENT);
#pragma unroll
        for (int ai = 0; ai < 2; ++ai) {
            if (ai == 1) {
#pragma unroll
                for (int m = 0; m < 4; ++m)
#pragma unroll
                    for (int bj = 0; bj < 2; ++bj) hraw[m][bj] = *(const u32x4*)(HB + (size_t)(row0 + 128 + m * 16) * D + colb + bj * 128);
            }
#pragma unroll
            for (int m = 0; m < 4; ++m) {
                const int row = row0 + ai * 128 + m * 16;
                const float rstd = rsqrtf(tot[ai][m] * (FIXI / D) + EPS);
                float s2 = 0.f;
#pragma unroll
                for (int bj = 0; bj < 2; ++bj) {
                    float h[8]; unpack8(hraw[m][bj], h);
                    const f32x4 v0 = acc[ai][bj][m][0], v1 = acc[ai][bj][m][1];
                    h[0] += v0[0] * rstd * g[bj][0]; h[1] += v0[1] * rstd * g[bj][1]; h[2] += v0[2] * rstd * g[bj][2]; h[3] += v0[3] * rstd * g[bj][3];
                    h[4] += v1[0] * rstd * g[bj][4]; h[5] += v1[1] * rstd * g[bj][5]; h[6] += v1[2] * rstd * g[bj][6]; h[7] += v1[3] * rstd * g[bj][7];
#pragma unroll
                    for (int e = 0; e < 8; ++e) s2 += h[e] * h[e];
                    *(u32x4*)(HB + (size_t)row * D + colb + bj * 128) = pack8(h);
                }
                s2 += __shfl_xor(s2, 16); s2 += __shfl_xor(s2, 32);
                if (fq == 0) (void)__hip_atomic_fetch_add(ssq2 + row, (i64)(s2 * FIXS + 0.5f), __ATOMIC_RELAXED, __HIP_MEMORY_SCOPE_AGENT);
            }
            asm volatile("" ::: "memory");
        }
        if (done) {
            __builtin_amdgcn_fence(__ATOMIC_RELEASE, "agent"); asm volatile("s_waitcnt vmcnt(0)" ::: "memory");
            if (fr == 0 && fq == 0) (void)__hip_atomic_fetch_add(done, 1u, __ATOMIC_RELAXED, __HIP_MEMORY_SCOPE_AGENT);
        }
    }
};
__device__ __forceinline__ void run_gemm_res(unsigned char* lds, const u16* A, const u16* Bt, int K, const EpiRes& E, int part) {
    pg8::Gemm g{A, Bt, MPAD, D, K}; SplitOrder S; S.init(MPAD, D, (int)ogdim(), (int)obid()); S.part = part; S.ready = nullptr; S.hz = 0;
    pg8::gemm_phase<EpiRes, SplitOrder, true, true>((LAS unsigned char*)lds, g, S, E);
}

__device__ __forceinline__ void conv_tile(unsigned char* lds, const float* src, int ld, int col0, const float* gain, u16* dst, int K, int n0, int k0) {
    float* tile = (float*)lds;
    const int tid = otid();
#pragma unroll
    for (int i = 0; i < 2; ++i) { const int e = tid + 512 * i, kk = e >> 4, n4 = (e & 15) * 4;
        f32x4 v = *(const f32x4*)(src + (size_t)(k0 + kk) * ld + col0 + n4); if (gain) v = v * gain[k0 + kk];
        tile[kk * 65 + n4] = v[0]; tile[kk * 65 + n4 + 1] = v[1]; tile[kk * 65 + n4 + 2] = v[2]; tile[kk * 65 + n4 + 3] = v[3]; }
    __syncthreads();
    { const int kq = tid & 7, nn = tid >> 3; float o[8];
#pragma unroll
      for (int j = 0; j < 8; ++j) o[j] = tile[(8 * kq + j) * 65 + nn];
      *(u32x4*)(dst + (size_t)(n0 + nn) * K + k0 + 8 * kq) = pack8(o); }
    __syncthreads();
}

__device__ void phase0(const Params& p, unsigned char* lds) {
    unsigned char* ws = p.ws;
    const int tid = otid(), lane = tid & 63, wave = tid >> 6;
    for (int i = obid() * 512 + tid; i < 2048; i += ogdim() * 512) {
        const float l0 = p.in[12][i], l1 = p.in[12][2048 + i];
        ((float*)(ws + OFF_LB))[i] = 1.0f / (1.0f + expf(l0 - l1));
    }
    u16* HB = (u16*)(ws + OFF_HB); i64* RS = (i64*)(ws + OFF_SQA);
    for (int row = obid() * 8 + wave; row < MPAD; row += ogdim() * 8) {
        u32x4 w0 = {0u, 0u, 0u, 0u}, w1 = {0u, 0u, 0u, 0u}; float rsv = 0.f;
        if (row < MTOK) {
            int s, t, L; row_decode(row, s, t, L);
            const float* src = (t < 16) ? p.in[2] + (size_t)t * D : (s < 8 ? p.in[0] + ((size_t)s * SS + (t - 16)) * D : p.in[1] + ((size_t)(s - 8) * SL + (t - 16)) * D);
            const f32x4 a = *(const f32x4*)(src + lane * 16), b = *(const f32x4*)(src + lane * 16 + 4), c = *(const f32x4*)(src + lane * 16 + 8), d = *(const f32x4*)(src + lane * 16 + 12);
            float ss = a[0] * a[0] + a[1] * a[1] + a[2] * a[2] + a[3] * a[3] + b[0] * b[0] + b[1] * b[1] + b[2] * b[2] + b[3] * b[3]
                     + c[0] * c[0] + c[1] * c[1] + c[2] * c[2] + c[3] * c[3] + d[0] * d[0] + d[1] * d[1] + d[2] * d[2] + d[3] * d[3];
            ss = wave_sum(ss); rsv = ss;
            w0.x = pk_bf(a[0], a[1]); w0.y = pk_bf(a[2], a[3]); w0.z = pk_bf(b[0], b[1]); w0.w = pk_bf(b[2], b[3]);
            w1.x = pk_bf(c[0], c[1]); w1.y = pk_bf(c[2], c[3]); w1.z = pk_bf(d[0], d[1]); w1.w = pk_bf(d[2], d[3]);
        }
        *(u32x4*)(HB + (size_t)row * D + lane * 16) = w0; *(u32x4*)(HB + (size_t)row * D + lane * 16 + 8) = w1;
        if (lane == 0) RS[row] = (i64)(rsv * FIXS + 0.5f);
    }
    for (int job = obid(); job < 11008; job += ogdim()) {
        int idx = job; const float* src; int ld, col0, K, n0, k0; const float* gain = nullptr; u16* dst;
        if (idx < 8448) {
            const int lf = idx / 2112, l = lf >> 1, f = lf & 1; int r = idx - lf * 2112;
            u16* wl = (u16*)(ws + (l ? OFF_W1 : OFF_W0));
            if (r < 1408) { const int nt = r >> 4, kt = r & 15; n0 = nt * 64; k0 = kt * 64; K = D; ld = DFF;
                const int t256 = n0 >> 8, within = n0 & 255;
                if (within < 128) { src = p.in[5] + (size_t)lf * D * DFF; col0 = t256 * 128 + within; } else { src = p.in[6] + (size_t)lf * D * DFF; col0 = t256 * 128 + within - 128; }
                gain = p.in[3] + (l * 3 + (f ? 2 : 0)) * D; dst = wl + (f ? WE_GU1 : WE_GU0);
            } else { r -= 1408; const int nt = r / 44, kt = r - nt * 44; n0 = nt * 64; k0 = kt * 64; K = DFF; ld = D; src = p.in[7] + (size_t)lf * DFF * D; col0 = n0; dst = wl + (f ? WE_DN1 : WE_DN0); }
        } else {
            idx -= 8448;
            if (idx < 768) { const int nt = idx >> 4, kt = idx & 15; n0 = nt * 64; k0 = kt * 64; K = D; ld = 3 * D; src = p.in[8]; gain = p.in[3] + 1 * D; dst = (u16*)(ws + OFF_W0) + WE_MIXIN;
                if (n0 < 1024) col0 = n0; else { const int t = (n0 - 1024) >> 8, within = (n0 - 1024) & 255; col0 = within < 128 ? 1024 + t * 128 + within : 2048 + t * 128 + within - 128; }
            } else if (idx < 1024) { idx -= 768; const int nt = idx >> 4, kt = idx & 15; n0 = nt * 64; k0 = kt * 64; K = D; ld = D; src = p.in[10]; col0 = n0; dst = (u16*)(ws + OFF_W0) + WE_SCOUT;
            } else if (idx < 2304) { idx -= 1024; const int nt = idx >> 4, kt = idx & 15; n0 = nt * 64; k0 = kt * 64; K = D; ld = 5 * D; src = p.in[11]; col0 = n0; gain = p.in[3] + 4 * D; dst = (u16*)(ws + OFF_W1) + WE_MIXIN;
            } else { idx -= 2304; const int nt = idx >> 4, kt = idx & 15; n0 = nt * 64; k0 = kt * 64; K = D; ld = D; src = p.in[14]; col0 = n0; dst = (u16*)(ws + OFF_W1) + WE_HGOUT; }
        }
        conv_tile(lds, src, ld, col0, gain, dst, K, n0, k0);
    }
}

__device__ void row_update(const u16* F, const float* ssq, const float* gpost, float coef, u16* HB, float* RS, float* out, const float* gfinal, int r_lo, int r_hi, int bidx, int nblk) {
    const int lane = otid() & 63, wave = otid() >> 6;
    float g[16];
#pragma unroll
    for (int q = 0; q < 4; ++q) { const f32x4 gv = *(const f32x4*)(gpost + lane * 16 + q * 4); g[q * 4] = gv[0] * coef; g[q * 4 + 1] = gv[1] * coef; g[q * 4 + 2] = gv[2] * coef; g[q * 4 + 3] = gv[3] * coef; }
    const int nw = nblk * 8;
    f32x4 gfin[4];
#pragma unroll
    for (int q = 0; q < 4; ++q) gfin[q] = out ? *(const f32x4*)(gfinal + lane * 16 + q * 4) : (f32x4){0.f, 0.f, 0.f, 0.f};
    for (int row0 = r_lo + bidx * 8 + wave; row0 < r_hi; row0 += 2 * nw) {
        const int row1 = row0 + nw; const bool has1 = row1 < r_hi; const int r1 = has1 ? row1 : row0;
        float ssa = lane < 16 ? ssq[(size_t)lane * MPAD + row0] : 0.f, ssb = lane < 16 ? ssq[(size_t)lane * MPAD + r1] : 0.f;
        const u32x4 fa0 = *(const u32x4*)(F + (size_t)row0 * D + lane * 16), fa1 = *(const u32x4*)(F + (size_t)row0 * D + lane * 16 + 8);
        const u32x4 fb0 = *(const u32x4*)(F + (size_t)r1 * D + lane * 16), fb1 = *(const u32x4*)(F + (size_t)r1 * D + lane * 16 + 8);
        const u32x4 ha0 = *(const u32x4*)(HB + (size_t)row0 * D + lane * 16), ha1 = *(const u32x4*)(HB + (size_t)row0 * D + lane * 16 + 8);
        const u32x4 hb0 = *(const u32x4*)(HB + (size_t)r1 * D + lane * 16), hb1 = *(const u32x4*)(HB + (size_t)r1 * D + lane * 16 + 8);
#pragma unroll
        for (int o = 1; o < 16; o <<= 1) { ssa += __shfl_xor(ssa, o); ssb += __shfl_xor(ssb, o); }
        ssa = __shfl(ssa, 0); ssb = __shfl(ssb, 0);
        const float rsa = rsqrtf(ssa * (1.0f / D) + EPS), rsb = rsqrtf(ssb * (1.0f / D) + EPS);
        float fa[16], fb[16], ha[16], hb[16];
        unpack8(fa0, *(float(*)[8])&fa[0]); unpack8(fa1, *(float(*)[8])&fa[8]); unpack8(fb0, *(float(*)[8])&fb[0]); unpack8(fb1, *(float(*)[8])&fb[8]);
        unpack8(ha0, *(float(*)[8])&ha[0]); unpack8(ha1, *(float(*)[8])&ha[8]); unpack8(hb0, *(float(*)[8])&hb[0]); unpack8(hb1, *(float(*)[8])&hb[8]);
        float s2a = 0.f, s2b = 0.f;
#pragma unroll
        for (int e = 0; e < 16; ++e) { ha[e] = ha[e] + fa[e] * rsa * g[e]; s2a += ha[e] * ha[e]; hb[e] = hb[e] + fb[e] * rsb * g[e]; s2b += hb[e] * hb[e]; }
#pragma unroll
        for (int o = 1; o < 64; o <<= 1) { s2a += __shfl_xor(s2a, o); s2b += __shfl_xor(s2b, o); }
        const float ra = rsqrtf(s2a * (1.0f / D) + EPS), rb = rsqrtf(s2b * (1.0f / D) + EPS);
        if (!out) {
        *(u32x4*)(HB + (size_t)row0 * D + lane * 16) = pack8(*(float(*)[8])&ha[0]); *(u32x4*)(HB + (size_t)row0 * D + lane * 16 + 8) = pack8(*(float(*)[8])&ha[8]);
        if (lane == 0) RS[row0] = ra;
        }
        if (has1 && !out) { *(u32x4*)(HB + (size_t)row1 * D + lane * 16) = pack8(*(float(*)[8])&hb[0]); *(u32x4*)(HB + (size_t)row1 * D + lane * 16 + 8) = pack8(*(float(*)[8])&hb[8]); if (lane == 0) RS[row1] = rb; }
        if (out) {
#pragma unroll
            for (int rr = 0; rr < 2; ++rr) {
                const int row = rr ? row1 : row0; if (rr && !has1) break;
                int sq, t, L; row_decode(row, sq, t, L);
                if (t >= 16) {
                    const size_t orow = sq < 8 ? (size_t)sq * SS + (t - 16) : (size_t)8 * SS + (size_t)(sq - 8) * SL + (t - 16);
                    const float rr2 = rr ? rb : ra;
#pragma unroll
                    for (int q = 0; q < 4; ++q) { const f32x4 gv = gfin[q];
                        f32x4 o; const float* hh = rr ? hb : ha; o[0] = hh[q * 4] * rr2 * gv[0]; o[1] = hh[q * 4 + 1] * rr2 * gv[1]; o[2] = hh[q * 4 + 2] * rr2 * gv[2]; o[3] = hh[q * 4 + 3] * rr2 * gv[3];
                        *(f32x4*)(out + orow * D + lane * 16 + q * 4) = o; }
                }
            }
        }
    }
}

__device__ void conv_phase(u16* GB, const u16* Z, const float* wconv) {
    const int c = (otid() & 127) * 8;
    float w0[8], w1[8], w2[8];
#pragma unroll
    for (int e = 0; e < 8; ++e) { w0[e] = wconv[c + e]; w1[e] = wconv[D + c + e]; w2[e] = wconv[2 * D + c + e]; }
    const int nrb = MTOK / 8;
    for (int rb = obid() * 4 + (otid() >> 7); rb < nrb; rb += (int)ogdim() * 4) {
        const int r0 = rb * 8;
        int s, t, L; row_decode(r0, s, t, L);
        u32x4 zr[10], gr[8];
        zr[0] = (t > 0) ? *(const u32x4*)(Z + (size_t)(r0 - 1) * D + c) : (u32x4){0u, 0u, 0u, 0u};
#pragma unroll
        for (int i = 0; i < 8; ++i) { zr[i + 1] = *(const u32x4*)(Z + (size_t)(r0 + i) * D + c); gr[i] = *(const u32x4*)(GB + (size_t)(r0 + i) * D + c); }
        zr[9] = (t + 8 < L) ? *(const u32x4*)(Z + (size_t)(r0 + 8) * D + c) : (u32x4){0u, 0u, 0u, 0u};
        float zp[8], zc[8], zn[8];
        unpack8(zr[0], zp); unpack8(zr[1], zc);
#pragma unroll
        for (int i = 0; i < 8; ++i) {
            unpack8(zr[i + 2], zn);
            float gb[8], y[8]; unpack8(gr[i], gb);
#pragma unroll
            for (int e = 0; e < 8; ++e) { y[e] = gb[e] * (w0[e] * zp[e] + w1[e] * zc[e] + w2[e] * zn[e]); zp[e] = zc[e]; zc[e] = zn[e]; }
            *(u32x4*)(GB + (size_t)(r0 + i) * D + c) = pack8(y);
        }
    }
}

__device__ void gate_norm_phase(u16* O, const u16* G0, const u16* G1, const float* gn, int r_lo, int r_hi, int bidx, int nblk) {
    const int lane = otid() & 63, wave = otid() >> 6;
    float gv[16];
#pragma unroll
    for (int q = 0; q < 4; ++q) { const f32x4 a = *(const f32x4*)(gn + lane * 16 + q * 4); gv[q * 4] = a[0]; gv[q * 4 + 1] = a[1]; gv[q * 4 + 2] = a[2]; gv[q * 4 + 3] = a[3]; }
    const int nw = nblk * 8;
    for (int row0 = r_lo + bidx * 8 + wave; row0 < r_hi; row0 += 2 * nw) {
        const int row1 = row0 + nw; const bool has1 = row1 < r_hi; const int r1 = has1 ? row1 : row0;
        const u32x4 oa0 = *(const u32x4*)(O + (size_t)row0 * D + lane * 16), oa1 = *(const u32x4*)(O + (size_t)row0 * D + lane * 16 + 8);
        const u16* Ga = row0 < G_SPLIT ? G0 + (size_t)row0 * D : G1 + (size_t)(row0 - G_SPLIT) * D; const u16* Gb = r1 < G_SPLIT ? G0 + (size_t)r1 * D : G1 + (size_t)(r1 - G_SPLIT) * D;
        const u32x4 ga0 = *(const u32x4*)(Ga + lane * 16), ga1 = *(const u32x4*)(Ga + lane * 16 + 8);
        const u32x4 ob0 = *(const u32x4*)(O + (size_t)r1 * D + lane * 16), ob1 = *(const u32x4*)(O + (size_t)r1 * D + lane * 16 + 8);
        const u32x4 gb0 = *(const u32x4*)(Gb + lane * 16), gb1 = *(const u32x4*)(Gb + lane * 16 + 8);
        float oa[16], ga[16], ob[16], gb[16];
        unpack8(oa0, *(float(*)[8])&oa[0]); unpack8(oa1, *(float(*)[8])&oa[8]); unpack8(ga0, *(float(*)[8])&ga[0]); unpack8(ga1, *(float(*)[8])&ga[8]);
        unpack8(ob0, *(float(*)[8])&ob[0]); unpack8(ob1, *(float(*)[8])&ob[8]); unpack8(gb0, *(float(*)[8])&gb[0]); unpack8(gb1, *(float(*)[8])&gb[8]);
        float sa = 0.f, sb = 0.f;
#pragma unroll
        for (int e = 0; e < 16; ++e) { oa[e] *= ga[e]; sa += oa[e] * oa[e]; ob[e] *= gb[e]; sb += ob[e] * ob[e]; }
        sa += __shfl_xor(sa, 1); sa += __shfl_xor(sa, 2); sa += __shfl_xor(sa, 4);
        sb += __shfl_xor(sb, 1); sb += __shfl_xor(sb, 2); sb += __shfl_xor(sb, 4);
        const float ra = rsqrtf(sa * (1.0f / 128.0f) + EPS), rb = rsqrtf(sb * (1.0f / 128.0f) + EPS);
#pragma unroll
        for (int e = 0; e < 16; ++e) { oa[e] = oa[e] * ra * gv[e]; ob[e] = ob[e] * rb * gv[e]; }
        *(u32x4*)(O + (size_t)row0 * D + lane * 16) = pack8(*(float(*)[8])&oa[0]); *(u32x4*)(O + (size_t)row0 * D + lane * 16 + 8) = pack8(*(float(*)[8])&oa[8]);
        if (has1) { *(u32x4*)(O + (size_t)row1 * D + lane * 16) = pack8(*(float(*)[8])&ob[0]); *(u32x4*)(O + (size_t)row1 * D + lane * 16 + 8) = pack8(*(float(*)[8])&ob[8]); }
    }
}

constexpr int L_QH = 0, L_KH = 17408, L_KT = 34816, L_VT = 53248, L_P = 71680, L_ST = 80896, L_TOT = 115712, L_ER = 119808, L_E2 = 120320;
constexpr int PQ = 136, PT = 72;

__device__ __forceinline__ int seq_nb(int s) { return s < 8 ? 4 : 32; }
__device__ __forceinline__ int seq_sb(int s) { return s < 8 ? 4 * s : 32 + 32 * (s - 8); }
__device__ __forceinline__ int slot_index(int s, int j, int head, int dir) { return ((seq_sb(s) + j) * 8 + head) * 2 + dir; }
__device__ __forceinline__ bf16x8 lds_frag(const unsigned char* lds, int byteoff) { return *(const bf16x8*)(lds + byteoff); }

struct ChunkRegs { unsigned k[8], v[8], q[8]; };
template <bool FULL>
__device__ __forceinline__ void chunk_prefetch(ChunkRegs& R, const u16* Qp, const u16* Kp, const u16* Vp, int row0, int col0, int tid) {
    const size_t g = (size_t)(row0 + 8 * (tid >> 6)) * D + col0 + 2 * (tid & 63);
#pragma unroll
    for (int i = 0; i < 8; ++i) { R.k[i] = *(const unsigned*)(Kp + g + (size_t)i * D); R.v[i] = *(const unsigned*)(Vp + g + (size_t)i * D); if (FULL) R.q[i] = *(const unsigned*)(Qp + g + (size_t)i * D); }
}
typedef float f32x2s __attribute__((ext_vector_type(2)));
#define LP(T, off) ((LAS T*)(lds + (off)))

template <bool FULL, bool BWD>
__device__ __forceinline__ void scan_chunk(LAS unsigned char* lds, ChunkRegs& R, const u16* nQp, const u16* nKp, const u16* nVp, int nrow0, bool has_next,
                                           u16* Of, u16* Oo, int row0, int nvalid, int col0, f32x4 (&S)[8], float (&dls)[2]) {
    constexpr bool bwd = BWD;
    const int tid = otid(), lane = tid & 63, w = tid >> 6, fr = lane & 15, fq = lane >> 4;
    const int cp = lane, tg = w;
    f32x2s G[8], kv[8], qv[8]; unsigned vw[8];
#pragma unroll
    for (int i = 0; i < 8; ++i) {
        const bool valid = (8 * tg + i) < nvalid;
        const unsigned kw = valid ? R.k[i] : 0u;
        kv[i] = (f32x2s){h2f((u16)(kw & 0xffffu)), h2f((u16)(kw >> 16))};
        const f32x2s fv = 1.0f - kv[i];
        G[i] = (f32x2s){fmaxf(fv.x, 1e-6f), fmaxf(fv.y, 1e-6f)};
        if (FULL) qv[i] = (f32x2s){__uint_as_float(R.q[i] << 16), __uint_as_float(R.q[i] & 0xffff0000u)};
        vw[i] = R.v[i];
    }
    f32x2s pr = {1.f, 1.f};
    if (!bwd) {
#pragma unroll
        for (int i = 0; i < 8; ++i) { pr = pr * G[i]; pr = (f32x2s){fmaxf(pr.x, 1e-30f), fmaxf(pr.y, 1e-30f)}; G[i] = pr; }
    } else {
#pragma unroll
        for (int i = 7; i >= 0; --i) { pr = pr * G[i]; pr = (f32x2s){fmaxf(pr.x, 1e-30f), fmaxf(pr.y, 1e-30f)}; G[i] = pr; }
    }
    *LP(f32x2s, L_TOT + (tg * 128 + 2 * cp) * 4) = (f32x2s){__logf(pr.x), __logf(pr.y)};
    if (has_next) chunk_prefetch<FULL>(R, nQp, nKp, nVp, nrow0, col0, tid);
    __syncthreads();
    {
        f32x2s t[8];
#pragma unroll
        for (int g = 0; g < 8; ++g) t[g] = *LP(f32x2s, L_TOT + (g * 128 + 2 * cp) * 4);
        const f32x2s lo4 = (t[0] + t[1]) + (t[2] + t[3]), hi4 = (t[4] + t[5]) + (t[6] + t[7]);
        const f32x2s BL = lo4 + hi4, r = bwd ? hi4 : lo4;
        f32x2s off = {0.f, 0.f};
#pragma unroll
        for (int g = 0; g < 8; ++g) { const bool take = bwd ? (g > tg) : (g < tg); if (take) off += t[g]; }
        const f32x2s cq = {__expf(fminf(off.x - r.x, 80.f)), __expf(fminf(off.y - r.y, 80.f))};
        const f32x2s ck = {__expf(fminf(r.x - off.x, 80.f)), __expf(fminf(r.y - off.y, 80.f))};
        unsigned khp[8];
#pragma unroll
        for (int i = 0; i < 8; ++i) {
            const int tl = 8 * tg + i;
            f32x2s m = ck * (f32x2s){__builtin_amdgcn_rcpf(G[i].x), __builtin_amdgcn_rcpf(G[i].y)};
            m = (f32x2s){fminf(m.x, 1e30f), fminf(m.y, 1e30f)};
            const f32x2s kh = kv[i] * m;
            khp[i] = pk_bf(kh.x, kh.y);
            if (FULL) {
                *LP(unsigned, L_KH + (tl * PQ + 2 * cp) * 2) = khp[i];
                const f32x2s qh = qv[i] * (cq * G[i]);
                *LP(unsigned, L_QH + (tl * PQ + 2 * cp) * 2) = pk_bf(qh.x, qh.y);
            }
        }
        u32x4 a, b;
        a.x = (khp[0] & 0xffffu) | (khp[1] << 16); a.y = (khp[2] & 0xffffu) | (khp[3] << 16); a.z = (khp[4] & 0xffffu) | (khp[5] << 16); a.w = (khp[6] & 0xffffu) | (khp[7] << 16);
        b.x = (khp[0] >> 16) | (khp[1] & 0xffff0000u); b.y = (khp[2] >> 16) | (khp[3] & 0xffff0000u); b.z = (khp[4] >> 16) | (khp[5] & 0xffff0000u); b.w = (khp[6] >> 16) | (khp[7] & 0xffff0000u);
        *LP(u32x4, L_KT + ((2 * cp) * PT + 8 * tg) * 2) = a; *LP(u32x4, L_KT + ((2 * cp + 1) * PT + 8 * tg) * 2) = b;
        a.x = (vw[0] & 0xffffu) | (vw[1] << 16); a.y = (vw[2] & 0xffffu) | (vw[3] << 16); a.z = (vw[4] & 0xffffu) | (vw[5] << 16); a.w = (vw[6] & 0xffffu) | (vw[7] << 16);
        b.x = (vw[0] >> 16) | (vw[1] & 0xffff0000u); b.y = (vw[2] >> 16) | (vw[3] & 0xffff0000u); b.z = (vw[4] >> 16) | (vw[5] & 0xffff0000u); b.w = (vw[6] >> 16) | (vw[7] & 0xffff0000u);
        *LP(u32x4, L_VT + ((2 * cp) * PT + 8 * tg) * 2) = a; *LP(u32x4, L_VT + ((2 * cp + 1) * PT + 8 * tg) * 2) = b;
        if (tg == 0) { *LP(f32x2s, L_ER + 2 * cp * 4) = (f32x2s){__expf(r.x), __expf(r.y)}; *LP(f32x2s, L_E2 + 2 * cp * 4) = (f32x2s){__expf(BL.x - r.x), __expf(BL.y - r.y)};
            dls[0] += BL.x; dls[1] += BL.y; }
    }
    __syncthreads();
    {
        const f32x4 er4 = *LP(f32x4, L_ER + (16 * w + 4 * fq) * 4);
#pragma unroll
        for (int i = 0; i < 8; ++i) {
            S[i] = S[i] * er4;
            if (FULL) { u32x2 pk; pk.x = pk_bf(S[i][0], S[i][1]); pk.y = pk_bf(S[i][2], S[i][3]); *LP(u32x2, L_ST + ((16 * i + fr) * PQ + 16 * w + 4 * fq) * 2) = pk; }
        }
    }
    const int tt = w & 3, hf = w >> 2;
    if (FULL) {
        bf16x8 qh[4], kf0[4], kf1[4];
#pragma unroll
        for (int kq = 0; kq < 4; ++kq) { qh[kq] = *LP(bf16x8, L_QH + ((16 * tt + fr) * PQ + 32 * kq + 8 * fq) * 2);
            kf0[kq] = *LP(bf16x8, L_KH + ((16 * (2 * hf) + fr) * PQ + 32 * kq + 8 * fq) * 2); kf1[kq] = *LP(bf16x8, L_KH + ((16 * (2 * hf + 1) + fr) * PQ + 32 * kq + 8 * fq) * 2); }
#pragma unroll
        for (int si = 0; si < 2; ++si) {
            const int st = 2 * hf + si;
            f32x4 acc = {0.f, 0.f, 0.f, 0.f};
#pragma unroll
            for (int kq = 0; kq < 4; ++kq)
                acc = __builtin_amdgcn_mfma_f32_16x16x32_bf16(si ? kf1[kq] : kf0[kq], qh[kq], acc, 0, 0, 0);
            const int tau = 16 * tt + fr, sg = 16 * st + 4 * fq;
            float pv[4];
#pragma unroll
            for (int j = 0; j < 4; ++j) { const bool keep = bwd ? (sg + j >= tau) : (sg + j <= tau); pv[j] = keep ? acc[j] : 0.f; }
            u32x2 pk; pk.x = pk_bf(pv[0], pv[1]); pk.y = pk_bf(pv[2], pv[3]);
            *LP(u32x2, L_P + (tau * PT + sg) * 2) = pk;
        }
        __syncthreads();
        f32x4 o[4];
        {
            bf16x8 pfr[2], sa[4], va2[2], sb[4], vb2[2];
#pragma unroll
            for (int sq = 0; sq < 2; ++sq) pfr[sq] = *LP(bf16x8, L_P + ((16 * tt + fr) * PT + 32 * sq + 8 * fq) * 2);
#pragma unroll
            for (int kq = 0; kq < 4; ++kq) sa[kq] = *LP(bf16x8, L_ST + ((16 * (4 * hf) + fr) * PQ + 32 * kq + 8 * fq) * 2);
#pragma unroll
            for (int sq = 0; sq < 2; ++sq) va2[sq] = *LP(bf16x8, L_VT + ((16 * (4 * hf) + fr) * PT + 32 * sq + 8 * fq) * 2);
#pragma unroll
            for (int i = 0; i < 4; i += 2) {
                const int vt1 = 4 * hf + i + 1;
#pragma unroll
                for (int kq = 0; kq < 4; ++kq) sb[kq] = *LP(bf16x8, L_ST + ((16 * vt1 + fr) * PQ + 32 * kq + 8 * fq) * 2);
#pragma unroll
                for (int sq = 0; sq < 2; ++sq) vb2[sq] = *LP(bf16x8, L_VT + ((16 * vt1 + fr) * PT + 32 * sq + 8 * fq) * 2);
                f32x4 acc = {0.f, 0.f, 0.f, 0.f};
#pragma unroll
                for (int kq = 0; kq < 4; ++kq) acc = __builtin_amdgcn_mfma_f32_16x16x32_bf16(sa[kq], qh[kq], acc, 0, 0, 0);
#pragma unroll
                for (int sq = 0; sq < 2; ++sq) acc = __builtin_amdgcn_mfma_f32_16x16x32_bf16(va2[sq], pfr[sq], acc, 0, 0, 0);
                o[i] = acc;
                if (i + 2 < 4) {
                    const int vt2 = 4 * hf + i + 2;
#pragma unroll
                    for (int kq = 0; kq < 4; ++kq) sa[kq] = *LP(bf16x8, L_ST + ((16 * vt2 + fr) * PQ + 32 * kq + 8 * fq) * 2);
#pragma unroll
                    for (int sq = 0; sq < 2; ++sq) va2[sq] = *LP(bf16x8, L_VT + ((16 * vt2 + fr) * PT + 32 * sq + 8 * fq) * 2);
                }
                f32x4 acc1 = {0.f, 0.f, 0.f, 0.f};
#pragma unroll
                for (int kq = 0; kq < 4; ++kq) acc1 = __builtin_amdgcn_mfma_f32_16x16x32_bf16(sb[kq], qh[kq], acc1, 0, 0, 0);
#pragma unroll
                for (int sq = 0; sq < 2; ++sq) acc1 = __builtin_amdgcn_mfma_f32_16x16x32_bf16(vb2[sq], pfr[sq], acc1, 0, 0, 0);
                o[i + 1] = acc1;
            }
        }
        const int tl = 16 * tt + fr;
        if (tl < nvalid) {
            const size_t ob = (size_t)(row0 + tl) * D + col0 + 64 * hf + 4 * fq;
            if (!bwd) {
#pragma unroll
                for (int i = 0; i < 4; ++i) { u32x2 pk; pk.x = pk_bf(o[i][0], o[i][1]); pk.y = pk_bf(o[i][2], o[i][3]); *(u32x2*)(Of + ob + 16 * i) = pk; }
            } else {
                u32x2 pf[4];
#pragma unroll
                for (int i = 0; i < 4; ++i) pf[i] = *(const u32x2*)(Of + ob + 16 * i);
#pragma unroll
                for (int i = 0; i < 4; ++i) {
                    const float a0 = o[i][0] + __uint_as_float(pf[i].x << 16), a1 = o[i][1] + __uint_as_float(pf[i].x & 0xffff0000u), a2 = o[i][2] + __uint_as_float(pf[i].y << 16), a3 = o[i][3] + __uint_as_float(pf[i].y & 0xffff0000u);
                    u32x2 pk; pk.x = pk_bf(a0, a1); pk.y = pk_bf(a2, a3); *(u32x2*)(Oo + ob + 16 * i) = pk; }
            }
        }
    }
    {
        bf16x8 ktf[2], vfa[4], vfb[4];
#pragma unroll
        for (int sq = 0; sq < 2; ++sq) { ktf[sq] = *LP(bf16x8, L_KT + ((16 * w + fr) * PT + 32 * sq + 8 * fq) * 2);
            vfa[sq] = *LP(bf16x8, L_VT + (fr * PT + 32 * sq + 8 * fq) * 2); vfa[2 + sq] = *LP(bf16x8, L_VT + ((16 + fr) * PT + 32 * sq + 8 * fq) * 2); }
#pragma unroll
        for (int i = 0; i < 8; i += 4) {
#pragma unroll
            for (int sq = 0; sq < 2; ++sq) { vfb[sq] = *LP(bf16x8, L_VT + ((16 * (i + 2) + fr) * PT + 32 * sq + 8 * fq) * 2); vfb[2 + sq] = *LP(bf16x8, L_VT + ((16 * (i + 3) + fr) * PT + 32 * sq + 8 * fq) * 2); }
#pragma unroll
            for (int sq = 0; sq < 2; ++sq) { S[i] = __builtin_amdgcn_mfma_f32_16x16x32_bf16(ktf[sq], vfa[sq], S[i], 0, 0, 0); S[i + 1] = __builtin_amdgcn_mfma_f32_16x16x32_bf16(ktf[sq], vfa[2 + sq], S[i + 1], 0, 0, 0); }
            if (i + 4 < 8) {
#pragma unroll
                for (int sq = 0; sq < 2; ++sq) { vfa[sq] = *LP(bf16x8, L_VT + ((16 * (i + 4) + fr) * PT + 32 * sq + 8 * fq) * 2); vfa[2 + sq] = *LP(bf16x8, L_VT + ((16 * (i + 5) + fr) * PT + 32 * sq + 8 * fq) * 2); }
            }
#pragma unroll
            for (int sq = 0; sq < 2; ++sq) { S[i + 2] = __builtin_amdgcn_mfma_f32_16x16x32_bf16(ktf[sq], vfb[sq], S[i + 2], 0, 0, 0); S[i + 3] = __builtin_amdgcn_mfma_f32_16x16x32_bf16(ktf[sq], vfb[2 + sq], S[i + 3], 0, 0, 0); }
        }
        const f32x4 e4 = *LP(f32x4, L_E2 + (16 * w + 4 * fq) * 4);
#pragma unroll
        for (int i = 0; i < 8; ++i) S[i] = S[i] * e4;
    }
}

__device__ __forceinline__ void block_chunks(int j, int nb, int& c_lo, int& c_hi) { c_lo = 8 * j; c_hi = (j == nb - 1) ? 8 * j + 9 : 8 * j + 8; }

__device__ __forceinline__ void state_load(const u16* slot, f32x4 (&S)[8], int w, int fr, int fq) {
#pragma unroll
    for (int i = 0; i < 8; ++i) { const u32x2 pk = *(const u32x2*)(slot + (16 * i + fr) * 128 + 16 * w + 4 * fq);
        S[i][0] = __uint_as_float(pk.x << 16); S[i][1] = __uint_as_float(pk.x & 0xffff0000u); S[i][2] = __uint_as_float(pk.y << 16); S[i][3] = __uint_as_float(pk.y & 0xffff0000u); }
}
__device__ __forceinline__ void state_zero(f32x4 (&S)[8]) {
#pragma unroll
    for (int i = 0; i < 8; ++i) S[i] = (f32x4){0.f, 0.f, 0.f, 0.f};
}

constexpr int LA_KT = 0, LA_VT = 34816, LA_TOT = 69632, LA_ER = 73728;
struct StepRegs { unsigned k[16], v[16]; };
__device__ __forceinline__ void step_prefetch(StepRegs& R, const u16* Kp, const u16* Vp, int row0, int col0, int tid) {
    const size_t g = (size_t)(row0 + 16 * (tid >> 6)) * D + col0 + 2 * (tid & 63);
#pragma unroll
    for (int i = 0; i < 16; ++i) { R.k[i] = *(const unsigned*)(Kp + g + (size_t)i * D); R.v[i] = *(const unsigned*)(Vp + g + (size_t)i * D); }
}
template <bool BWD>
__device__ __forceinline__ void scan_step_a(LAS unsigned char* lds, StepRegs& R, const u16* Kp, const u16* Vp, int nrow0, bool has_next, int nvalid, int col0, f32x4 (&S)[8], float (&dls)[2]) {
    const int tid = otid(), lane = tid & 63, w = tid >> 6, fr = lane & 15, fq = lane >> 4;
    const int cp = lane, tg = w;
    f32x2s kv[16], G[16]; unsigned vw[16];
#pragma unroll
    for (int i = 0; i < 16; ++i) {
        const bool valid = (16 * tg + i) < nvalid;
        const unsigned kw = valid ? R.k[i] : 0u;
        kv[i] = (f32x2s){h2f((u16)(kw & 0xffffu)), h2f((u16)(kw >> 16))};
        const f32x2s fv = 1.0f - kv[i];
        G[i] = (f32x2s){fmaxf(fv.x, 1e-6f), fmaxf(fv.y, 1e-6f)};
        vw[i] = valid ? R.v[i] : 0u;
    }
    f32x2s pr = {1.f, 1.f};
    if (!BWD) {
#pragma unroll
        for (int i = 15; i >= 0; --i) { const f32x2s fi = G[i]; G[i] = pr; pr = pr * fi; pr = (f32x2s){fmaxf(pr.x, 1e-30f), fmaxf(pr.y, 1e-30f)}; }
    } else {
#pragma unroll
        for (int i = 0; i < 16; ++i) { const f32x2s fi = G[i]; G[i] = pr; pr = pr * fi; pr = (f32x2s){fmaxf(pr.x, 1e-30f), fmaxf(pr.y, 1e-30f)}; }
    }
    *LP(f32x2s, LA_TOT + (tg * 128 + 2 * cp) * 4) = (f32x2s){__logf(pr.x), __logf(pr.y)};
    if (has_next) step_prefetch(R, Kp, Vp, nrow0, col0, tid);
    __syncthreads();
    {
        f32x2s t[8];
#pragma unroll
        for (int g = 0; g < 8; ++g) t[g] = *LP(f32x2s, LA_TOT + (g * 128 + 2 * cp) * 4);
        const f32x2s BL = ((t[0] + t[1]) + (t[2] + t[3])) + ((t[4] + t[5]) + (t[6] + t[7]));
        f32x2s off = {0.f, 0.f};
#pragma unroll
        for (int g = 0; g < 8; ++g) { const bool take = BWD ? (g < tg) : (g > tg); if (take) off += t[g]; }
        const f32x2s c = {__expf(off.x), __expf(off.y)};
        unsigned khp[16];
#pragma unroll
        for (int i = 0; i < 16; ++i) { const f32x2s kh = kv[i] * (c * G[i]); khp[i] = pk_bf(kh.x, kh.y); }
#pragma unroll
        for (int h = 0; h < 2; ++h) {
            u32x4 a, b;
            a.x = (khp[8 * h + 0] & 0xffffu) | (khp[8 * h + 1] << 16); a.y = (khp[8 * h + 2] & 0xffffu) | (khp[8 * h + 3] << 16); a.z = (khp[8 * h + 4] & 0xffffu) | (khp[8 * h + 5] << 16); a.w = (khp[8 * h + 6] & 0xffffu) | (khp[8 * h + 7] << 16);
            b.x = (khp[8 * h + 0] >> 16) | (khp[8 * h + 1] & 0xffff0000u); b.y = (khp[8 * h + 2] >> 16) | (khp[8 * h + 3] & 0xffff0000u); b.z = (khp[8 * h + 4] >> 16) | (khp[8 * h + 5] & 0xffff0000u); b.w = (khp[8 * h + 6] >> 16) | (khp[8 * h + 7] & 0xffff0000u);
            *LP(u32x4, LA_KT + ((2 * cp) * PQ + 16 * tg + 8 * h) * 2) = a; *LP(u32x4, LA_KT + ((2 * cp + 1) * PQ + 16 * tg + 8 * h) * 2) = b;
            a.x = (vw[8 * h + 0] & 0xffffu) | (vw[8 * h + 1] << 16); a.y = (vw[8 * h + 2] & 0xffffu) | (vw[8 * h + 3] << 16); a.z = (vw[8 * h + 4] & 0xffffu) | (vw[8 * h + 5] << 16); a.w = (vw[8 * h + 6] & 0xffffu) | (vw[8 * h + 7] << 16);
            b.x = (vw[8 * h + 0] >> 16) | (vw[8 * h + 1] & 0xffff0000u); b.y = (vw[8 * h + 2] >> 16) | (vw[8 * h + 3] & 0xffff0000u); b.z = (vw[8 * h + 4] >> 16) | (vw[8 * h + 5] & 0xffff0000u); b.w = (vw[8 * h + 6] >> 16) | (vw[8 * h + 7] & 0xffff0000u);
            *LP(u32x4, LA_VT + ((2 * cp) * PQ + 16 * tg + 8 * h) * 2) = a; *LP(u32x4, LA_VT + ((2 * cp + 1) * PQ + 16 * tg + 8 * h) * 2) = b;
        }
        if (tg == 0) { *LP(f32x2s, LA_ER + 2 * cp * 4) = (f32x2s){__expf(BL.x), __expf(BL.y)}; dls[0] += BL.x; dls[1] += BL.y; }
    }
    __syncthreads();
    const f32x4 er4 = *LP(f32x4, LA_ER + (16 * w + 4 * fq) * 4);
    bf16x8 kt[4], va[4], vb[4];
#pragma unroll
    for (int sq = 0; sq < 4; ++sq) { kt[sq] = *LP(bf16x8, LA_KT + ((16 * w + fr) * PQ + 32 * sq + 8 * fq) * 2); va[sq] = *LP(bf16x8, LA_VT + (fr * PQ + 32 * sq + 8 * fq) * 2); }
#pragma unroll
    for (int i = 0; i < 8; i += 2) {
#pragma unroll
        for (int sq = 0; sq < 4; ++sq) vb[sq] = *LP(bf16x8, LA_VT + ((16 * (i + 1) + fr) * PQ + 32 * sq + 8 * fq) * 2);
        S[i] = S[i] * er4;
#pragma unroll
        for (int sq = 0; sq < 4; ++sq) S[i] = __builtin_amdgcn_mfma_f32_16x16x32_bf16(kt[sq], va[sq], S[i], 0, 0, 0);
        if (i + 2 < 8) {
#pragma unroll
            for (int sq = 0; sq < 4; ++sq) va[sq] = *LP(bf16x8, LA_VT + ((16 * (i + 2) + fr) * PQ + 32 * sq + 8 * fq) * 2);
        }
        S[i + 1] = S[i + 1] * er4;
#pragma unroll
        for (int sq = 0; sq < 4; ++sq) S[i + 1] = __builtin_amdgcn_mfma_f32_16x16x32_bf16(kt[sq], vb[sq], S[i + 1], 0, 0, 0);
    }
}

__device__ void scan_pass_a(unsigned char* ldsg, const u16* KF, const u16* KB, const u16* V, u16* STs, float* DL) {
    LAS unsigned char* lds = (LAS unsigned char*)ldsg;
    const int tid = otid(), lane = tid & 63, w = tid >> 6, fr = lane & 15, fq = lane >> 4;
    for (int item = obid(); item < 1376; item += ogdim()) {
        const int hd = item / 86, rem = item - hd * 86, head = hd >> 1, dir = hd & 1;
        int s, jj; if (rem < 24) { s = rem / 3; jj = rem - 3 * s; } else { const int r2 = rem - 24; const int q = r2 / 31; s = 8 + q; jj = r2 - 31 * q; }
        const int nb = seq_nb(s), L = s < 8 ? LS : LL, j = dir ? jj + 1 : jj;
        int c_lo, c_hi; block_chunks(j, nb, c_lo, c_hi);
        f32x4 S[8]; state_zero(S); float dls[2] = {0.f, 0.f};
        const int base = seq_base(s), col0 = head * 128;
        const int tb = 64 * c_lo, te = (64 * c_hi < L) ? 64 * c_hi : L;
        const int ns = (te - tb + 127) >> 7;
        const u16* Kp = dir ? KB : KF;
        StepRegs R;
        step_prefetch(R, Kp, V, base + tb + 128 * (dir ? ns - 1 : 0), col0, tid);
        if (dir) {
            for (int si = ns - 1; si >= 0; --si) { const int t0 = tb + 128 * si; const int nvalid = (te - t0) < 128 ? (te - t0) : 128;
                scan_step_a<true>(lds, R, Kp, V, base + t0 - 128, si > 0, nvalid, col0, S, dls); }
        } else {
            for (int si = 0; si < ns; ++si) { const int t0 = tb + 128 * si; const int nvalid = (te - t0) < 128 ? (te - t0) : 128;
                scan_step_a<false>(lds, R, Kp, V, base + t0 + 128, si + 1 < ns, nvalid, col0, S, dls); }
        }
        const int sl = slot_index(s, j, head, dir);
        u16* slot = STs + (size_t)sl * 16384;
#pragma unroll
        for (int i = 0; i < 8; ++i) { u32x2 pk; pk.x = pk_bf(S[i][0], S[i][1]); pk.y = pk_bf(S[i][2], S[i][3]); *(u32x2*)(slot + (16 * i + fr) * 128 + 16 * w + 4 * fq) = pk; }
        if (tid < 64) *(f32x2s*)(DL + (size_t)sl * 128 + 2 * tid) = (f32x2s){dls[0], dls[1]};
        __syncthreads();
    }
}

__device__ void scan_pass_b(u16* STs, const float* DL) {
    const int tid = otid();
    for (int item = obid(); item < 1280; item += ogdim()) {
        const int slice = item & 7, shd = item >> 3, dir = shd & 1, head = (shd >> 1) & 7, s = shd >> 4;
        const int nb = seq_nb(s); const int e = slice * 2048 + tid * 4, k = e & 127;
        float S0 = 0.f, S1 = 0.f, S2 = 0.f, S3 = 0.f;
        for (int q0 = 0; q0 < nb - 1; q0 += 4) {
            u32x2 pk[4]; f32x4 dl[4]; u16* sp[4];
#pragma unroll
            for (int b = 0; b < 4; ++b) {
                const int q = (q0 + b < nb - 1) ? q0 + b : nb - 2; const int j = dir ? nb - 1 - q : q;
                const int sl = slot_index(s, j, head, dir);
                sp[b] = STs + (size_t)sl * 16384 + e; pk[b] = *(const u32x2*)sp[b]; dl[b] = *(const f32x4*)(DL + (size_t)sl * 128 + k);
            }
#pragma unroll
            for (int b = 0; b < 4; ++b) {
                if (q0 + b < nb - 1) {
                    S0 = __expf(dl[b][0]) * S0 + __uint_as_float(pk[b].x << 16); S1 = __expf(dl[b][1]) * S1 + __uint_as_float(pk[b].x & 0xffff0000u);
                    S2 = __expf(dl[b][2]) * S2 + __uint_as_float(pk[b].y << 16); S3 = __expf(dl[b][3]) * S3 + __uint_as_float(pk[b].y & 0xffff0000u);
                    u32x2 o; o.x = pk_bf(S0, S1); o.y = pk_bf(S2, S3); *(u32x2*)sp[b] = o;
                }
            }
        }
    }
}

__device__ void scan_pass_c(unsigned char* ldsg, u16* Q, u16* KF, const u16* KB, const u16* V, const u16* STs) {
    LAS unsigned char* lds = (LAS unsigned char*)ldsg;
    const int tid = otid(), lane = tid & 63, w = tid >> 6, fr = lane & 15, fq = lane >> 4;
    for (int item = obid(); item < 768; item += ogdim()) {
        const int head = item & 7, bj = item >> 3;
        int s, j; if (bj < 32) { s = bj >> 2; j = bj & 3; } else { s = 8 + ((bj - 32) >> 5); j = (bj - 32) & 31; }
        const int nb = seq_nb(s), L = s < 8 ? LS : LL, base = seq_base(s), col0 = head * 128;
        int c_lo, c_hi; block_chunks(j, nb, c_lo, c_hi);
        const int nc = c_hi - c_lo;
        f32x4 S[8]; float dls[2] = {0.f, 0.f};
        ChunkRegs R;
        chunk_prefetch<true>(R, Q, KF, V, base + 64 * c_lo, col0, tid);
        if (j == 0) state_zero(S); else state_load(STs + (size_t)slot_index(s, j - 1, head, 0) * 16384, S, w, fr, fq);
        for (int ci = 0; ci < nc; ++ci) {
            const int c = c_lo + ci; const int t0 = 64 * c; const int nvalid = (L - t0) < 64 ? (L - t0) : 64;
            const bool lastc = (ci + 1 == nc);
            scan_chunk<true, false>(lds, R, Q, lastc ? KB : (const u16*)KF, V, base + 64 * (lastc ? c : c + 1), true, KF, Q, base + t0, nvalid, col0, S, dls);
        }
        if (j == nb - 1) state_zero(S); else state_load(STs + (size_t)slot_index(s, j + 1, head, 1) * 16384, S, w, fr, fq);
        for (int ci = 0; ci < nc; ++ci) {
            const int c = c_hi - 1 - ci; const int t0 = 64 * c; const int nvalid = (L - t0) < 64 ? (L - t0) : 64;
            scan_chunk<true, true>(lds, R, Q, KB, V, base + 64 * (c - 1), ci + 1 < nc, KF, Q, base + t0, nvalid, col0, S, dls);
        }
    }
}

#define XB_TMO      128
#define XB_XCNT(j)  (256  + 64 * (j))
#define XB_XSUB(j)  (1280 + 64 * (j))
#define XB_XGEN(j)  (2304 + 64 * (j))
#define XB_TOP      3328
#define XB_TOPGEN   3392
#define XCD_BAR_WORDS 3456
#define XB_SPIN_CAP (1u << 18)
__device__ __forceinline__ unsigned xb_ld(unsigned* p)              { return __hip_atomic_load(p, __ATOMIC_RELAXED, __HIP_MEMORY_SCOPE_AGENT); }
__device__ __forceinline__ unsigned xb_add(unsigned* p, unsigned v) { return __hip_atomic_fetch_add(p, v, __ATOMIC_RELAXED, __HIP_MEMORY_SCOPE_AGENT); }
__device__ __forceinline__ unsigned xb_xcc_id() { return (unsigned)__builtin_amdgcn_s_getreg((3 << 11) | 20) & 0xFu; }
#define XB_SPIN(cond, bar) do { unsigned _sp = 0; while (cond) { __builtin_amdgcn_s_sleep(1); \
    if ((++_sp & 255u) == 0u) { if (xb_ld(&(bar)[XB_TMO])) break; if (_sp > XB_SPIN_CAP) { atomicAdd(&(bar)[XB_TMO], 1u); break; } } } } while (0)
struct XcdBarrier { unsigned* bar; unsigned x; volatile LAS unsigned* st; };
__device__ __forceinline__ XcdBarrier xcd_barrier_post(unsigned* bar, volatile LAS unsigned* st) {
    XcdBarrier b; b.bar = bar; b.x = xb_xcc_id(); b.st = st;
    if (threadIdx.x == 0) (void)xb_add(&bar[XB_XCNT(b.x)], 1u);
    return b;
}
__device__ __forceinline__ void xcd_barrier_complete(unsigned* bar, unsigned x, unsigned& nloc, unsigned& nx) {
    const unsigned G = gridDim.x * gridDim.y * gridDim.z;
    unsigned sum, cnt, mine, sp = 0u;
    for (;;) {
        sum = 0u; cnt = 0u; mine = 0u;
#pragma unroll
        for (unsigned j = 0; j < 16; ++j) { const unsigned c = xb_ld(&bar[XB_XCNT(j)]); sum += c; cnt += (c > 0u) ? 1u : 0u; mine = (j == x) ? c : mine; }
        if (sum == G) break;
        __builtin_amdgcn_s_sleep(1);
        if ((++sp & 255u) == 0u) { if (xb_ld(&bar[XB_TMO])) break; if (sp > XB_SPIN_CAP) { atomicAdd(&bar[XB_TMO], 1u); break; } }
    }
    nloc = mine > 0u ? mine : 1u; nx = cnt > 0u ? cnt : 1u;
}
__device__ __forceinline__ void xcd_barrier(const XcdBarrier& b) {
    asm volatile("s_waitcnt vmcnt(0)" ::: "memory");
    __syncthreads();
    if (threadIdx.x == 0) {
        unsigned* bar = b.bar;
        __builtin_amdgcn_s_waitcnt(0);
        unsigned nloc = b.st[0], nx = b.st[1];
        if (nloc == 0u) { xcd_barrier_complete(bar, b.x, nloc, nx); b.st[0] = nloc; b.st[1] = nx; }
        const unsigned old = xb_add(&bar[XB_XSUB(b.x)], 1u);
        const unsigned gen = old / nloc;
        if (old + 1u == (gen + 1u) * nloc) {
            __builtin_amdgcn_fence(__ATOMIC_RELEASE, "agent");
            asm volatile("s_waitcnt vmcnt(0)" ::: "memory");
            const unsigned og = xb_add(&bar[XB_TOP], 1u);
            const unsigned tg = og / nx;
            if (og + 1u == (tg + 1u) * nx) xb_add(&bar[XB_TOPGEN], 1u);
            else XB_SPIN(xb_ld(&bar[XB_TOPGEN]) == tg, bar);
            __builtin_amdgcn_fence(__ATOMIC_ACQUIRE, "agent");
            xb_add(&bar[XB_XGEN(b.x)], 1u);
            asm volatile("s_waitcnt vmcnt(0)" ::: "memory");
        } else {
            XB_SPIN(xb_ld(&bar[XB_XGEN(b.x)]) == gen, bar);
            __builtin_amdgcn_fence(__ATOMIC_ACQUIRE, "agent");
            asm volatile("s_waitcnt vmcnt(0)" ::: "memory");
        }
    }
    __syncthreads();
}

#ifndef MK_LAUNCHES
#define MK_LAUNCHES 1
#endif

__device__ __forceinline__ void mini_barrier(unsigned* word, unsigned nb) {
    asm volatile("s_waitcnt vmcnt(0)" ::: "memory");
    __syncthreads();
    if (threadIdx.x == 0) {
        __builtin_amdgcn_fence(__ATOMIC_RELEASE, "agent");
        asm volatile("s_waitcnt vmcnt(0)" ::: "memory");
        xb_add(word, 1u);
        unsigned sp = 0;
        while (xb_ld(word) < nb) { __builtin_amdgcn_s_sleep(1); if (++sp > (1u << 22)) break; }
        __builtin_amdgcn_fence(__ATOMIC_ACQUIRE, "agent");
        asm volatile("s_waitcnt vmcnt(0)" ::: "memory");
    }
    __syncthreads();
}
constexpr int N_PHASES = 19;
constexpr int ROWS_MAIN = 192 * 256;
__device__ __forceinline__ void run_phase(const int ph, const Params& p, unsigned char* lds) {
    int kind, l = 0, f = 0, sub = 0, gk = 0;
    if (ph == 0) kind = 0;
    else if (ph <= 2) { kind = ph == 1 ? 1 : 16; gk = 2; }
    else if (ph <= 5) { sub = 1; kind = ph == 3 ? 4 : (ph == 4 ? 5 : 16); gk = 6; }
    else if (ph <= 7) { sub = 2; f = 1; kind = ph == 6 ? 1 : 16; gk = 2; }
    else if (ph <= 9) { sub = 3; l = 1; kind = ph == 8 ? 1 : 16; gk = 2; }
    else if (ph <= 15) { sub = 4; l = 1; kind = ph <= 12 ? ph - 2 : (ph == 13 ? 11 : (ph == 14 ? 13 : 16)); gk = 14; }
    else { sub = 5; l = 1; f = 1; kind = ph - 15; }
    unsigned char* ws = p.ws;
    const bool last = (ph >= 16);
    const i64* sqcur = (const i64*)(ws + ((sub & 1) ? OFF_SQB : OFF_SQA));
    i64* sqnext = (i64*)(ws + ((sub & 1) ? OFF_SQA : OFF_SQB));
    const int bid = obid();
    const bool rowk = (kind == 3 || kind == 7 || kind == 15);
    const bool left1 = rowk && bid < 4;
    const bool left4 = (kind == 13) && bid < 4;
    if (kind == 0) { phase0(p, lds); return; }
    const int cpb = (bid & 7) * ((int)ogdim() >> 3) + (bid >> 3);
    const bool after_down = (ph == 3 || ph == 6 || ph == 8 || ph == 10 || ph == 16);
    const int hz = (ph == 6 || ph == 16) ? 1 : 0;
    const bool leftR = after_down && cpb < 4;
    const unsigned* ready = after_down ? (const unsigned*)(ws + OFF_DONE) : nullptr;
    if (kind == 1 || kind == 4 || kind == 8) {
        i64* sq1 = (i64*)(ws + OFF_SQ1); unsigned* cnt = (unsigned*)(ws + OFF_CNT);
        for (int i = bid * 512 + otid(); i < MPAD; i += (int)ogdim() * 512) { sq1[i] = 0; sqnext[i] = 0; if (i < 193) cnt[64 * i] = 0u; }
    }
    if (kind == 16 || leftR) {
        int el = l, ef = f, egk = gk;
        if (leftR) { egk = (ph == 6) ? 6 : (ph == 16 ? 14 : 2); el = (ph == 10 || ph == 16) ? 1 : 0; ef = (ph == 8) ? 1 : 0; }
        if (!leftR && bid == 0 && otid() < 256) { ((i64*)(ws + OFF_SQ1L))[otid()] = 0; if (otid() == 0) { *(unsigned*)(ws + OFF_CNTL) = 0u; *(unsigned*)(ws + OFF_DONE) = 0u; } }
        const size_t wbase = el ? OFF_W1 : OFF_W0;
        const size_t boff = (egk == 2) ? (ef ? WE_DN1 : WE_DN0) : (egk == 6 ? WE_SCOUT : WE_HGOUT);
        const int which = (egk == 2) ? (ef ? 2 : 0) : 1;
        EpiRes E{(u16*)(ws + OFF_HB), leftR ? (i64*)(ws + OFF_SQ1L) - ROWS_MAIN : (i64*)(ws + OFF_SQ1), leftR ? (i64*)sqcur : sqnext,
                 leftR ? (unsigned*)(ws + OFF_CNTL) - 64 * 192 : (unsigned*)(ws + OFF_CNT), p.in[4] + (el * 3 + which) * D, egk == 2 ? 0.5f : 1.0f, leftR ? (unsigned*)(ws + OFF_DONE) : nullptr};
        run_gemm_res(lds, (const u16*)(ws + OFF_ACT), (const u16*)(ws + wbase) + boff, egk == 2 ? DFF : D, E, leftR ? 4 : 5);
        if (!leftR) return;
    }
    if (kind == 1) {
        const u16* WL = (const u16*)(ws + (l ? OFF_W1 : OFF_W0));
        Epi<0> E{sqcur, (u16*)(ws + OFF_ACT), nullptr, nullptr, nullptr, nullptr, nullptr};
        run_gemm<0>(lds, (const u16*)(ws + OFF_HB), WL + (f ? WE_GU1 : WE_GU0), 2 * DFF, D, E, 0, ready, hz); return;
    }
    if (kind == 2 || kind == 6 || kind == 14 || left1) {
        const int gk = left1 ? kind - 1 : kind;
        const size_t wbase = l ? OFF_W1 : OFF_W0;
        const size_t boff = (gk == 2) ? (f ? WE_DN1 : WE_DN0) : (gk == 6 ? WE_SCOUT : WE_HGOUT);
        const int K = (gk == 2) ? DFF : D;
        const size_t foff = (gk == 2 && last) ? OFF_FF : 0;
        unsigned char* fbase = (gk == 2 && last) ? ws : (unsigned char*)p.out;
        Epi<1> E{nullptr, (u16*)(fbase + foff), nullptr, nullptr, nullptr, (float*)(ws + OFF_SSQ), nullptr};
        run_gemm<1>(lds, (const u16*)(ws + OFF_ACT), (const u16*)(ws + wbase) + boff, D, K, E, left1 ? 2 : 1);
        if (!left1) return;
        mini_barrier((unsigned*)(ws + OFF_BAR + 14336) + 64 * (ph & 7) + (ph >> 3) * 8, 4u);
    }
    if (rowk) {
        const int which = (kind == 3) ? (f ? 2 : 0) : 1;
        const u16* F = last ? (const u16*)(ws + OFF_FF) : (const u16*)p.out;
        row_update(F, (const float*)(ws + OFF_SSQ), p.in[4] + (l * 3 + which) * D, kind == 3 ? 0.5f : 1.0f, (u16*)(ws + OFF_HB), (float*)(ws + OFF_RS), last ? p.out : nullptr, p.in[15],
                   left1 ? ROWS_MAIN : 0, left1 ? MTOK : ROWS_MAIN, left1 ? bid : bid - 4, left1 ? 4 : (int)ogdim() - 4); return;
    }
    u16* B0 = (u16*)(ws + OFF_ACT); u16* B1 = (u16*)(ws + OFF_ACT + SZ_ROWS); u16* B2 = (u16*)(ws + OFF_FF);
    if (kind == 4) { Epi<2> E{sqcur, B0, B1, nullptr, nullptr, nullptr, nullptr}; run_gemm<2>(lds, (const u16*)(ws + OFF_HB), (const u16*)(ws + OFF_W0) + WE_MIXIN, 3072, D, E, 0, ready); return; }
    if (kind == 5) { conv_phase(B0, B1, p.in[9]); return; }
    if (kind == 8) { Epi<3> E{sqcur, B0, (u16*)p.out, B1, B2, nullptr, (const float*)(ws + OFF_LB)}; run_gemm<3>(lds, (const u16*)(ws + OFF_HB), (const u16*)(ws + OFF_W1) + WE_MIXIN, 4096, D, E, 0, ready); return; }
    if (kind == 9) { scan_pass_a(lds, B1, B2, (const u16*)p.out, (u16*)(ws + OFF_ST), (float*)(ws + OFF_DL)); return; }
    u16* G0 = (u16*)((unsigned char*)p.out + SZ_ROWS); u16* G1 = (u16*)(ws + OFF_ST + (size_t)1536 * 32768);
    if (kind == 10) scan_pass_b((u16*)(ws + OFF_ST), (const float*)(ws + OFF_DL));
    if (kind == 11) { scan_pass_c(lds, B0, B1, B2, (const u16*)p.out, (const u16*)(ws + OFF_ST)); return; }
    if (kind == 10 || left4) { Epi<4> E{sqcur, G0, G1, nullptr, nullptr, nullptr, nullptr}; run_gemm<4>(lds, (const u16*)(ws + OFF_HB), (const u16*)(ws + OFF_W1) + WE_MIXIN + (size_t)4096 * D, D, D, E, left4 ? 2 : 1);
        if (!left4) return;
        mini_barrier((unsigned*)(ws + OFF_BAR + 14336) + 64 * (ph & 7) + (ph >> 3) * 8, 4u); }
    if (kind == 13) { gate_norm_phase(B0, G0, G1, p.in[13], left4 ? ROWS_MAIN : 0, left4 ? MTOK : ROWS_MAIN, left4 ? bid : bid - 4, left4 ? 4 : (int)ogdim() - 4); return; }
}

__global__ void __launch_bounds__(512) fwd_megakernel(Params p) {
    extern __shared__ __attribute__((aligned(16))) unsigned char lds[];
    volatile LAS unsigned* stw = (volatile LAS unsigned*)((LAS unsigned char*)lds + 131072);
    if (threadIdx.x < 4) stw[threadIdx.x] = 0u;
    __syncthreads();
    if (blockIdx.x == 0) { unsigned* bw = (unsigned*)(p.ws + OFF_BAR); for (int i = threadIdx.x; i < 4096; i += 512) bw[i] = 0u; }
    XcdBarrier bar; bar.bar = (unsigned*)(p.ws + OFF_BAR); bar.x = 0; bar.st = stw;
#pragma unroll 1
    for (int ph = p.ph_lo; ph < p.ph_hi; ++ph) {
        run_phase(ph, p, lds);
        if (MK_LAUNCHES == 1 && ph + 1 < p.ph_hi) {
            if (ph == 0) { cg::this_grid().sync(); bar = xcd_barrier_post((unsigned*)(p.ws + OFF_BAR), stw); }
            else xcd_barrier(bar);
        }
    }
}

extern "C" void kernel_launch(void* const* d_in, const int* in_sizes, int n_in, void* d_out, int out_size, void* d_ws, size_t ws_size, hipStream_t stream) {
    static int grid = 0;
    if (grid == 0) {
        if (n_in != 16 || ws_size < WS_NEED) { fprintf(stderr, "kernel_launch: bad arguments (n_in %d, ws %zu < %zu)\n", n_in, ws_size, (size_t)WS_NEED); grid = -1; return; }
        int dev = 0, cus = 0, per_cu = 0;
        (void)hipGetDevice(&dev); (void)hipDeviceGetAttribute(&cus, hipDeviceAttributeMultiprocessorCount, dev);
        if (hipFuncSetAttribute((const void*)fwd_megakernel, hipFuncAttributeMaxDynamicSharedMemorySize, LDS_BYTES) != hipSuccess) { fprintf(stderr, "kernel_launch: hipFuncSetAttribute failed\n"); grid = -1; return; }
        if (hipOccupancyMaxActiveBlocksPerMultiprocessor(&per_cu, (const void*)fwd_megakernel, 512, LDS_BYTES) != hipSuccess || per_cu < 1) { fprintf(stderr, "kernel_launch: occupancy query gave %d\n", per_cu); per_cu = 1; }
        (void)hipGetLastError();
        grid = cus * 1;
    }
    if (grid < 0) return;
    Params p{};
    for (int i = 0; i < 16; ++i) p.in[i] = (const float*)d_in[i];
    p.out = (float*)d_out; p.ws = (unsigned char*)d_ws;
#if MK_LAUNCHES == 1
    p.ph_lo = 0; p.ph_hi = N_PHASES;
    void* args[] = {&p};
    hipError_t e = hipLaunchCooperativeKernel((const void*)fwd_megakernel, dim3(grid), dim3(512), args, LDS_BYTES, stream);
    if (e != hipSuccess) fprintf(stderr, "cooperative launch failed: %s (grid %d)\n", hipGetErrorString(e), grid);
#else
    for (int k = 0; k < N_PHASES; ++k) { p.ph_lo = k; p.ph_hi = k + 1; hipLaunchKernelGGL(fwd_megakernel, dim3(grid), dim3(512), LDS_BYTES, stream, p); }
#endif
}
```
